# Optimizing an MI355X kernel written in HIP

```python
import math
import jax
import jax.numpy as jnp
from jax import lax
import numpy as np

D_MODEL = 1024
BATCH = 8
SEQ = 2048
DEPTH = 1
DEC_BATCH = 128
DEC_SEQ = 1
PAST_LEN = 16384
PAGE_SIZE = 128

D_LRU = D_MODEL
LRU_BLOCKS = 16
LRU_BLOCK_W = D_LRU // LRU_BLOCKS
LRU_C = 8.0
SSD_EXPAND = 2
D_SSD = SSD_EXPAND * D_MODEL
SSD_HEAD_DIM = 64
SSD_HEADS = D_SSD // SSD_HEAD_DIM
SSD_GROUPS = 4
SSD_HPG = SSD_HEADS // SSD_GROUPS
SSD_STATE = 128
SSD_CHUNK = 128
SSD_CONV_DIM = D_SSD + 2 * SSD_GROUPS * SSD_STATE
CONV_W = 4
N_IN = 2 * D_LRU + D_SSD + SSD_CONV_DIM + SSD_HEADS + 2 * D_MODEL
LN_EPS = 1e-5
RMS_EPS = 1e-5
DEEPNORM_ALPHA = (2.0 * DEPTH) ** 0.25
DEEPNORM_BETA = (8.0 * DEPTH) ** -0.25

kernel_name = "hawk_ssd_parallel_gated_deepnorm_adaln_step"


def _layer_norm(x, g, b):
    xf = x.astype(jnp.float32)
    mu = jnp.mean(xf, -1, keepdims=True)
    var = jnp.mean(jnp.square(xf - mu), -1, keepdims=True)
    return ((xf - mu) * lax.rsqrt(var + LN_EPS) * g + b).astype(x.dtype)


def _causal_conv(u, buf, w, b):
    T = u.shape[1]
    up = jnp.concatenate([buf.astype(u.dtype), u], axis=1)
    out = b + w[0] * up[:, 0:T]
    for k in range(1, CONV_W):
        out = out + w[k] * up[:, k:k + T]
    return out, up[:, -(CONV_W - 1):]


def _linear_scan(a, b, h0):
    b = b.at[:, 0].add(a[:, 0] * h0)
    def comb(l, r):
        return (l[0] * r[0], r[0] * l[1] + r[1])
    _, h = lax.associative_scan(comb, (a, b), axis=1)
    return h


def _rg_lru(u, h0, wa, ba, wx, bx, lam, seq_start):
    Bn, T, _ = u.shape
    uf = u.astype(jnp.float32)
    ub = uf.reshape(Bn, T, LRU_BLOCKS, LRU_BLOCK_W)
    r = jax.nn.sigmoid(jnp.einsum('btnk,nkj->btnj', ub, wa).reshape(Bn, T, D_LRU) + ba)
    i = jax.nn.sigmoid(jnp.einsum('btnk,nkj->btnj', ub, wx).reshape(Bn, T, D_LRU) + bx)
    log_a = -LRU_C * r * jax.nn.softplus(-lam.astype(jnp.float32))
    a = jnp.exp(log_a)
    mult = jnp.sqrt(-jnp.expm1(2.0 * log_a))
    if seq_start:
        mult = mult.at[:, 0].set(1.0)
    h = _linear_scan(a, mult * i * uf, h0.astype(jnp.float32))
    return h, h[:, -1]


def _ssd(xh, dt, A, Bm, Cm, h0):
    Bn, T = xh.shape[0], xh.shape[1]
    L = min(SSD_CHUNK, T)
    nc = -(-T // L)
    pad = nc * L - T
    if pad:
        pw = lambda t: jnp.pad(t, [(0, 0), (0, pad)] + [(0, 0)] * (t.ndim - 2))
        xh, dt, Bm, Cm = pw(xh), pw(dt), pw(Bm), pw(Cm)
    xs = (xh.astype(jnp.float32) * dt[..., None]).reshape(Bn, nc, L, SSD_GROUPS, SSD_HPG, SSD_HEAD_DIM)
    a = (dt * A).reshape(Bn, nc, L, SSD_GROUPS, SSD_HPG)
    acs = jnp.transpose(jnp.cumsum(a, axis=2), (0, 1, 3, 4, 2))
    Bc = Bm.astype(jnp.float32).reshape(Bn, nc, L, SSD_GROUPS, SSD_STATE)
    Cc = Cm.astype(jnp.float32).reshape(Bn, nc, L, SSD_GROUPS, SSD_STATE)
    mask = jnp.tril(jnp.ones((L, L), dtype=bool))
    seg = acs[..., :, None] - acs[..., None, :]
    decay = jnp.exp(jnp.where(mask, seg, -jnp.inf))
    cb = jnp.einsum('bclgn,bcsgn->bcgls', Cc, Bc)
    y_diag = jnp.einsum('bcgls,bcghls,bcsghp->bclghp', cb, decay, xs)
    decay_end = jnp.exp(acs[..., -1:] - acs)
    states = jnp.einsum('bclgn,bcghl,bclghp->bcghpn', Bc, decay_end, xs)
    chunk_decay = jnp.exp(acs[..., -1])
    h0g = h0.astype(jnp.float32).reshape(Bn, SSD_GROUPS, SSD_HPG, SSD_HEAD_DIM, SSD_STATE)
    def step(h, inp):
        dec, s = inp
        return dec[..., None, None] * h + s, h
    h_last, h_in = lax.scan(step, h0g, (jnp.moveaxis(chunk_decay, 1, 0), jnp.moveaxis(states, 1, 0)))
    h_in = jnp.moveaxis(h_in, 0, 1)
    y_off = jnp.einsum('bclgn,bcghpn,bcghl->bclghp', Cc, h_in, jnp.exp(acs))
    y = (y_diag + y_off).reshape(Bn, nc * L, SSD_HEADS, SSD_HEAD_DIM)[:, :T]
    return y, h_last.reshape(Bn, SSD_HEADS, SSD_HEAD_DIM, SSD_STATE)


def _gated_rmsnorm(y, z, w):
    g = y.astype(jnp.float32) * jax.nn.silu(z.astype(jnp.float32))
    sh = g.shape
    gg = g.reshape(sh[:-1] + (SSD_GROUPS, D_SSD // SSD_GROUPS))
    gg = gg * lax.rsqrt(jnp.mean(gg * gg, -1, keepdims=True) + RMS_EPS)
    return gg.reshape(sh) * w


def _layer(x, c, lru_h0, lru_buf, ssd_h0, ssd_buf, seq_start,
           w_cond, b_cond, w_in, lru_conv_w, lru_conv_b, lru_wa, lru_ba, lru_wx, lru_bx, lru_lambda,
           ssd_conv_w, ssd_conv_b, ssd_dt_bias, ssd_a_log, ssd_d, ssd_norm_w,
           w_lru_proj, w_ssd_proj, w_out, ln_g, ln_b):
    Bn, T, _ = x.shape
    mod = c @ w_cond + b_cond
    shift, scale, gate = mod[:, :D_MODEL], mod[:, D_MODEL:2 * D_MODEL], mod[:, 2 * D_MODEL:]
    h = x * (1.0 + scale[:, None]) + shift[:, None]
    proj = h @ w_in
    o = 0
    lru_x = proj[..., o:o + D_LRU]; o += D_LRU
    lru_z = proj[..., o:o + D_LRU]; o += D_LRU
    ssd_z = proj[..., o:o + D_SSD]; o += D_SSD
    ssd_xbc = proj[..., o:o + SSD_CONV_DIM]; o += SSD_CONV_DIM
    ssd_dt = proj[..., o:o + SSD_HEADS]; o += SSD_HEADS
    merge_logits = proj[..., o:o + 2 * D_MODEL]
    u, lru_buf_new = _causal_conv(lru_x, lru_buf, lru_conv_w, lru_conv_b)
    hs, lru_h_new = _rg_lru(u, lru_h0, lru_wa, lru_ba, lru_wx, lru_bx, lru_lambda, seq_start)
    y_lru = hs * jax.nn.silu(lru_z.astype(jnp.float32))
    xbc, ssd_buf_new = _causal_conv(ssd_xbc, ssd_buf, ssd_conv_w, ssd_conv_b)
    xbc = jax.nn.silu(xbc)
    xs = xbc[..., :D_SSD].reshape(Bn, T, SSD_HEADS, SSD_HEAD_DIM)
    Bm = xbc[..., D_SSD:D_SSD + SSD_GROUPS * SSD_STATE].reshape(Bn, T, SSD_GROUPS, SSD_STATE)
    Cm = xbc[..., D_SSD + SSD_GROUPS * SSD_STATE:].reshape(Bn, T, SSD_GROUPS, SSD_STATE)
    dt = jax.nn.softplus((ssd_dt + ssd_dt_bias).astype(jnp.float32))
    A = -jnp.exp(ssd_a_log.astype(jnp.float32))
    y, ssd_h_new = _ssd(xs, dt, A, Bm, Cm, ssd_h0)
    y = y + ssd_d[:, None] * xs
    y_ssd = _gated_rmsnorm(y.reshape(Bn, T, D_SSD), ssd_z, ssd_norm_w)
    g = jax.nn.sigmoid(merge_logits.astype(jnp.float32))
    merged = g[..., :D_MODEL] * (y_lru @ w_lru_proj) + g[..., D_MODEL:] * (y_ssd @ w_ssd_proj)
    out = merged @ w_out
    x_new = _layer_norm(DEEPNORM_ALPHA * x + gate[:, None] * out, ln_g, ln_b).astype(x.dtype)
    return x_new, lru_h_new, lru_buf_new, ssd_h_new, ssd_buf_new


def setup_inputs(seed: int = 0) -> dict:
    key = jax.random.key(seed)
    ks = jax.random.split(key, 32)
    f32 = jnp.float32
    nrm = lambda k, shape, s: (jax.random.normal(k, shape, f32) * s)
    Dp = DEPTH
    a_c = jax.random.uniform(ks[20], (Dp, D_LRU), f32, 0.9, 0.999)
    s_l = a_c ** (1.0 / LRU_C)
    lru_lambda = jnp.log(s_l) - jnp.log1p(-s_l)
    dt0 = jnp.exp(jax.random.uniform(ks[21], (Dp, SSD_HEADS), f32, math.log(1e-3), math.log(1e-1)))
    ssd_dt_bias = dt0 + jnp.log(-jnp.expm1(-dt0))
    return {
        "x_prompt": nrm(ks[0], (BATCH, SEQ, D_MODEL), 1.0),
        "x_sample": nrm(ks[1], (DEC_BATCH, DEC_SEQ, D_MODEL), 1.0),
        "state_lru_h": nrm(ks[2], (Dp, DEC_BATCH, D_LRU), 0.5),
        "state_lru_conv": nrm(ks[3], (Dp, DEC_BATCH, CONV_W - 1, D_LRU), 1.0),
        "state_ssd_h": nrm(ks[4], (Dp, DEC_BATCH, SSD_HEADS, SSD_HEAD_DIM, SSD_STATE), 0.1),
        "state_ssd_conv": nrm(ks[5], (Dp, DEC_BATCH, CONV_W - 1, SSD_CONV_DIM), 1.0),
        "c_prompt": nrm(ks[6], (BATCH, D_MODEL), 1.0),
        "c_sample": nrm(ks[7], (DEC_BATCH, D_MODEL), 1.0),
        "w_cond": nrm(ks[8], (Dp, D_MODEL, 3 * D_MODEL), 0.2 * D_MODEL ** -0.5),
        "b_cond": nrm(ks[9], (Dp, 3 * D_MODEL), 0.02),
        "w_in": nrm(ks[10], (Dp, D_MODEL, N_IN), D_MODEL ** -0.5),
        "lru_conv_w": nrm(ks[11], (Dp, CONV_W, D_LRU), CONV_W ** -0.5),
        "lru_conv_b": nrm(ks[12], (Dp, D_LRU), 0.02),
        "lru_wa": nrm(ks[13], (Dp, LRU_BLOCKS, LRU_BLOCK_W, LRU_BLOCK_W), LRU_BLOCK_W ** -0.5),
        "lru_ba": nrm(ks[14], (Dp, D_LRU), 0.02),
        "lru_wx": nrm(ks[15], (Dp, LRU_BLOCKS, LRU_BLOCK_W, LRU_BLOCK_W), LRU_BLOCK_W ** -0.5),
        "lru_bx": nrm(ks[16], (Dp, D_LRU), 0.02),
        "lru_lambda": lru_lambda,
        "ssd_conv_w": nrm(ks[17], (Dp, CONV_W, SSD_CONV_DIM), CONV_W ** -0.5),
        "ssd_conv_b": nrm(ks[18], (Dp, SSD_CONV_DIM), 0.02),
        "ssd_dt_bias": ssd_dt_bias,
        "ssd_a_log": jnp.log(jax.random.uniform(ks[22], (Dp, SSD_HEADS), f32, 1.0, 16.0)),
        "ssd_d": 1.0 + nrm(ks[23], (Dp, SSD_HEADS), 0.1),
        "ssd_norm_w": 1.0 + nrm(ks[24], (Dp, D_SSD), 0.1),
        "w_lru_proj": nrm(ks[25], (Dp, D_LRU, D_MODEL), DEEPNORM_BETA * D_LRU ** -0.5),
        "w_ssd_proj": nrm(ks[26], (Dp, D_SSD, D_MODEL), DEEPNORM_BETA * D_SSD ** -0.5),
        "w_out": nrm(ks[27], (Dp, D_MODEL, D_MODEL), DEEPNORM_BETA * D_MODEL ** -0.5),
        "ln_g": 1.0 + nrm(ks[28], (Dp, D_MODEL), 0.1),
        "ln_b": nrm(ks[29], (Dp, D_MODEL), 0.02),
    }


def reference(x_prompt, x_sample, state_lru_h, state_lru_conv, state_ssd_h, state_ssd_conv,
              c_prompt, c_sample, w_cond, b_cond, w_in, lru_conv_w, lru_conv_b, lru_wa, lru_ba,
              lru_wx, lru_bx, lru_lambda, ssd_conv_w, ssd_conv_b, ssd_dt_bias, ssd_a_log, ssd_d,
              ssd_norm_w, w_lru_proj, w_ssd_proj, w_out, ln_g, ln_b):
    xp, xs = x_prompt, x_sample
    Bp = x_prompt.shape[0]
    dt_ = x_prompt.dtype
    p_lh, p_lc, p_sh, p_sc = [], [], [], []
    s_lh, s_lc, s_sh, s_sc = [], [], [], []
    for l in range(DEPTH):
        weights = (w_cond[l], b_cond[l], w_in[l], lru_conv_w[l], lru_conv_b[l], lru_wa[l], lru_ba[l],
                   lru_wx[l], lru_bx[l], lru_lambda[l], ssd_conv_w[l], ssd_conv_b[l], ssd_dt_bias[l],
                   ssd_a_log[l], ssd_d[l], ssd_norm_w[l], w_lru_proj[l], w_ssd_proj[l], w_out[l],
                   ln_g[l], ln_b[l])
        xp, a1, a2, a3, a4 = _layer(
            xp, c_prompt,
            jnp.zeros((Bp, D_LRU), jnp.float32),
            jnp.zeros((Bp, CONV_W - 1, D_LRU), dt_),
            jnp.zeros((Bp, SSD_HEADS, SSD_HEAD_DIM, SSD_STATE), jnp.float32),
            jnp.zeros((Bp, CONV_W - 1, SSD_CONV_DIM), dt_),
            True, *weights)
        p_lh.append(a1); p_lc.append(a2); p_sh.append(a3); p_sc.append(a4)
        xs, b1, b2, b3, b4 = _layer(
            xs, c_sample, state_lru_h[l], state_lru_conv[l], state_ssd_h[l], state_ssd_conv[l],
            False, *weights)
        s_lh.append(b1); s_lc.append(b2); s_sh.append(b3); s_sc.append(b4)
    return (xp, xs,
            jnp.stack(p_lh), jnp.stack(p_lc), jnp.stack(p_sh), jnp.stack(p_sc),
            jnp.stack(s_lh), jnp.stack(s_lc), jnp.stack(s_sh), jnp.stack(s_sc))
```

```cpp
#include <hip/hip_runtime.h>
#include <cstdio>
#include <cstdint>
namespace pg8 {
#define PG8_LAS __attribute__((address_space(3)))
typedef unsigned short bf16_t;
typedef short bf16x8 __attribute__((ext_vector_type(8)));
typedef float f32x4 __attribute__((ext_vector_type(4)));
typedef unsigned u32x4 __attribute__((ext_vector_type(4)));
constexpr int BM = 256, BK = 64, HALF = 128, HTB = HALF * BK * 2  , STAGE_BYTES = 8 * HTB, NXCD = 8, WGM = 8;

__host__ __device__ __forceinline__ int lds_byte(int r, int c) { const int st = (r >> 4) * 2 + (c >> 5), rr = r & 15, cc = c & 31, ob = rr * 64 + cc * 2; return st * 1024 + (ob ^ (((ob >> 9) & 1) << 5)); }
__host__ __device__ __forceinline__ void stage_rc(int b, int& R, int& C) { const int st = b / 1024, sb = b % 1024, swz = sb ^ (((sb >> 9) & 1) << 5); R = (st >> 1) * 16 + swz / 64; C = (st & 1) * 32 + (swz % 64) / 2; }
__host__ __device__ __forceinline__ int perm32(int rho) { const int n = rho >> 4, i = rho & 15; return 8 * (i >> 2) + 4 * n + (i & 3); }

struct Unit { int pm, pn; };
struct Gemm { const bf16_t* A; const bf16_t* Bt; int M, N, K; };

struct StaticOrder {
    int nM, nN, nwg, G, c;
    __host__ __device__ void init(int M, int N, int G_, int c_) { nM = M / BM; nN = N / BM; nwg = nM * nN; G = G_; c = c_; }
    __host__ __device__ bool next(int i, Unit& u) const {
        const long L = (long)i * G + c; if (L >= nwg) return false;
        int wgid = (int)L; { const int q = nwg / NXCD, r = nwg % NXCD, xcd = wgid % NXCD, off = wgid / NXCD; wgid = (xcd < r ? xcd * (q + 1) : r * (q + 1) + (xcd - r) * q) + off; }
        const int nig = WGM * nN, gid = wgid / nig, fm = gid * WGM, gsz = (nM - fm) < WGM ? (nM - fm) : WGM;
        u.pm = fm + ((wgid % nig) % gsz); u.pn = (wgid % nig) / gsz; return true;
    }
    __device__ __forceinline__ void a_ready(const Unit&) const {}
    __device__ __forceinline__ void done(const Unit&) const {}
};
__device__ __forceinline__ unsigned cvt_pk_bf16(float lo, float hi) { unsigned r; asm volatile("v_cvt_pk_bf16_f32 %0, %1, %2" : "=v"(r) : "v"(lo), "v"(hi)); return r; }
template <class Epi, class Sched, bool ALIGN_EPI = false, bool SP2 = false>
__device__ __forceinline__ void gemm_phase(PG8_LAS unsigned char* lds, const Gemm g, const Sched& S, const Epi& E) {
    const int tid = threadIdx.x, wid = __builtin_amdgcn_readfirstlane(tid >> 6), lane = tid & 63, wr = wid >> 2, wc = wid & 3, fr = lane & 15, fq = lane >> 4;
    const int K = g.K, nt = K / BK;
    unsigned voffA[2], voffB[2];
#pragma unroll
    for (int i = 0; i < 2; ++i) { int R, C; stage_rc(tid * 16 + i * 8192, R, C); const int Rb = Epi::PERM ? ((R & ~31) + perm32(R & 31)) : R;
        voffA[i] = (unsigned)(R * K + C) * 2u; voffB[i] = (unsigned)(Rb * K + C) * 2u; }
    const size_t kstep = (size_t)(BK * 2);
    const size_t hstep = (size_t)HALF * K * 2;
    const size_t tstep = 2 * hstep;
    const unsigned ldsw = (unsigned)wid * 1024u;
    const int aoff = lds_byte(wr * 64 + fr, fq * 8), boff = lds_byte(wc * 32 + fr, fq * 8);
#define PG8_SA(b, h) (((b) * 2 + (h)) * HTB)
#define PG8_SB(b, h) ((4 + (b) * 2 + (h)) * HTB)
#define PG8_STAGE(bufoff, gbase, voff) do { _Pragma("unroll") for (int _i = 0; _i < 2; ++_i) \
        __builtin_amdgcn_global_load_lds((const unsigned*)((const char*)(gbase) + (voff)[_i]), (PG8_LAS unsigned*)(lds + (bufoff) + ldsw + _i * 8192), 16, 0, 0); } while (0)
#define PG8_LDA(dst, b, h) do { _Pragma("unroll") for (int m = 0; m < 4; ++m) _Pragma("unroll") for (int k = 0; k < 2; ++k) dst[m][k] = *(const PG8_LAS bf16x8*)(lds + PG8_SA(b, h) + aoff + m * 2048 + k * 1024); } while (0)
#define PG8_LDB(dst, b, h) do { _Pragma("unroll") for (int n = 0; n < 2; ++n) _Pragma("unroll") for (int k = 0; k < 2; ++k) dst[n][k] = *(const PG8_LAS bf16x8*)(lds + PG8_SB(b, h) + boff + n * 2048 + k * 1024); } while (0)
#define PG8_MMA(ai, bj, At, Bt) do { __builtin_amdgcn_s_setprio(1); _Pragma("unroll") for (int m = 0; m < 4; ++m) _Pragma("unroll") for (int n = 0; n < 2; ++n) _Pragma("unroll") for (int k = 0; k < 2; ++k) \
        acc[ai][bj][m][n] = __builtin_amdgcn_mfma_f32_16x16x32_bf16(Bt[n][k], At[m][k], acc[ai][bj][m][n], 0, 0, 0); __builtin_amdgcn_s_setprio(0); } while (0)
#define PG8_WAIT_V(n) asm volatile("s_waitcnt vmcnt(" #n ")" ::: "memory")
#define PG8_WAIT_L(n) asm volatile("s_waitcnt lgkmcnt(" #n ")" ::: "memory")
#define PG8_BAR __builtin_amdgcn_s_barrier()
#define PG8_SCHED __builtin_amdgcn_sched_barrier(0)
    Unit cur, nxt; int ui = 0;
    if (!S.next(0, cur)) return;
    f32x4 acc[2][2][4][2];
#pragma unroll
    for (int a = 0; a < 2; ++a)
#pragma unroll
        for (int b = 0; b < 2; ++b)
#pragma unroll
            for (int m = 0; m < 4; ++m)
#pragma unroll
                for (int n = 0; n < 2; ++n) acc[a][b][m][n] = (f32x4){0.f, 0.f, 0.f, 0.f};
    bf16x8 At[4][2], B0[2][2], B1[2][2];
    const char* cA = (const char*)g.A + (size_t)cur.pm * tstep; const char* cB = (const char*)g.Bt + (size_t)cur.pn * tstep;
    S.a_ready(cur);
    if constexpr (SP2) {
        PG8_STAGE(PG8_SB(0, 0), cB, voffB); PG8_STAGE(PG8_SB(0, 1), cB + hstep, voffB); PG8_STAGE(PG8_SA(0, 0), cA, voffA); PG8_STAGE(PG8_SA(0, 1), cA + hstep, voffA);
        if (wr == 1) PG8_BAR;
        PG8_WAIT_V(2); PG8_BAR;
        PG8_STAGE(PG8_SB(1, 0), cB + kstep, voffB); PG8_STAGE(PG8_SA(1, 0), cA + kstep, voffA); PG8_STAGE(PG8_SB(1, 1), cB + hstep + kstep, voffB);
        PG8_WAIT_V(6); PG8_BAR;
    } else {
        PG8_STAGE(PG8_SB(0, 0), cB, voffB); PG8_STAGE(PG8_SA(0, 0), cA, voffA); PG8_STAGE(PG8_SB(0, 1), cB + hstep, voffB); PG8_STAGE(PG8_SA(0, 1), cA + hstep, voffA);
        if (wr == 1) PG8_BAR;
        PG8_WAIT_V(4); PG8_BAR;
        PG8_STAGE(PG8_SB(1, 0), cB + kstep, voffB); PG8_STAGE(PG8_SA(1, 0), cA + kstep, voffA); PG8_STAGE(PG8_SB(1, 1), cB + hstep + kstep, voffB);
        PG8_WAIT_V(6); PG8_BAR;
    }
    for (;;) {
        const bool has_next = S.next(ui + 1, nxt);
        const char* nA = has_next ? (const char*)g.A + (size_t)nxt.pm * tstep : cA; const char* nB = has_next ? (const char*)g.Bt + (size_t)nxt.pn * tstep : cB;
        for (int t = 0; t < nt; t += 2) {
            const bool last = (t == nt - 2);
            const char* a1 = cA + (size_t)(t + 1) * kstep;
            const char* a2 = last ? nA : cA + (size_t)(t + 2) * kstep; const char* b2 = last ? nB : cB + (size_t)(t + 2) * kstep;
            const char* a3 = a2 + kstep; const char* b3 = b2 + kstep;
            if (last && has_next) S.a_ready(nxt);
            if constexpr (Epi::HOOK) { if (t >= 8 && t <= 32 && (t & 7) == 0) E.hook(acc, cur, t, wr, wc, fr, fq); }
            if constexpr (SP2) {
            PG8_LDB(B0, 0, 0); PG8_LDB(B1, 0, 1); PG8_SCHED; PG8_LDA(At, 0, 0); PG8_STAGE(PG8_SA(1, 1), a1 + hstep, voffA);
            PG8_WAIT_V(8); PG8_WAIT_L(0); PG8_BAR; PG8_MMA(0, 0, At, B0); PG8_MMA(0, 1, At, B1); PG8_BAR; PG8_SCHED;
            PG8_LDA(At, 0, 1); PG8_STAGE(PG8_SB(0, 0), b2, voffB); PG8_STAGE(PG8_SB(0, 1), b2 + hstep, voffB); PG8_STAGE(PG8_SA(0, 0), a2, voffA);
            PG8_WAIT_V(8); PG8_WAIT_L(0); PG8_BAR; PG8_MMA(1, 0, At, B0); PG8_MMA(1, 1, At, B1); PG8_BAR; PG8_SCHED;
            PG8_LDB(B0, 1, 0); PG8_LDB(B1, 1, 1); PG8_SCHED; PG8_LDA(At, 1, 0); PG8_STAGE(PG8_SA(0, 1), a2 + hstep, voffA);
            PG8_WAIT_V(8); PG8_WAIT_L(0); PG8_BAR; PG8_MMA(0, 0, At, B0); PG8_MMA(0, 1, At, B1); PG8_BAR; PG8_SCHED;
            PG8_LDA(At, 1, 1); PG8_STAGE(PG8_SB(1, 0), b3, voffB); PG8_STAGE(PG8_SB(1, 1), b3 + hstep, voffB); PG8_STAGE(PG8_SA(1, 0), a3, voffA);
            PG8_WAIT_V(8); PG8_WAIT_L(0); PG8_BAR; PG8_MMA(1, 0, At, B0); PG8_MMA(1, 1, At, B1); PG8_BAR; PG8_SCHED;
            } else {
            PG8_LDB(B0, 0, 0); PG8_SCHED; PG8_LDA(At, 0, 0); PG8_STAGE(PG8_SA(1, 1), a1 + hstep, voffA);
            PG8_WAIT_L(8); PG8_BAR; PG8_WAIT_L(0); PG8_MMA(0, 0, At, B0); PG8_BAR; PG8_SCHED;
            PG8_LDB(B1, 0, 1); PG8_STAGE(PG8_SB(0, 0), b2, voffB);
            PG8_BAR; PG8_WAIT_L(0); PG8_MMA(0, 1, At, B1); PG8_BAR;
            PG8_LDA(At, 0, 1); PG8_STAGE(PG8_SA(0, 0), a2, voffA);
            PG8_BAR; PG8_WAIT_L(0); PG8_MMA(1, 0, At, B0); PG8_BAR; PG8_SCHED;
            PG8_STAGE(PG8_SB(0, 1), b2 + hstep, voffB);
            PG8_WAIT_V(6); PG8_BAR; PG8_MMA(1, 1, At, B1); PG8_BAR;
            PG8_LDB(B0, 1, 0); PG8_SCHED; PG8_LDA(At, 1, 0); PG8_STAGE(PG8_SA(0, 1), a2 + hstep, voffA);
            PG8_WAIT_L(8); PG8_BAR; PG8_WAIT_L(0); PG8_MMA(0, 0, At, B0); PG8_BAR; PG8_SCHED;
            PG8_LDB(B1, 1, 1); PG8_STAGE(PG8_SB(1, 0), b3, voffB);
            PG8_BAR; PG8_WAIT_L(0); PG8_MMA(0, 1, At, B1); PG8_BAR;
            PG8_LDA(At, 1, 1); PG8_STAGE(PG8_SA(1, 0), a3, voffA);
            PG8_BAR; PG8_WAIT_L(0); PG8_MMA(1, 0, At, B0); PG8_BAR; PG8_SCHED;
            PG8_STAGE(PG8_SB(1, 1), b3 + hstep, voffB);
            PG8_WAIT_V(6); PG8_BAR; PG8_MMA(1, 1, At, B1); PG8_BAR;
            }
        }
        if constexpr (ALIGN_EPI) { if (wr == 0) PG8_BAR; }
        if constexpr (!Epi::AFTER_DRAIN) { E(acc, cur, wr, wc, fr, fq); S.done(cur); }
        if (!has_next) break;
#pragma unroll
        for (int a = 0; a < 2; ++a)
#pragma unroll
            for (int b = 0; b < 2; ++b)
#pragma unroll
                for (int m = 0; m < 4; ++m)
#pragma unroll
                    for (int n = 0; n < 2; ++n) acc[a][b][m][n] = (f32x4){0.f, 0.f, 0.f, 0.f};
        cur = nxt; cA = nA; cB = nB; ++ui;
        if constexpr (ALIGN_EPI) { if (wr == 1) PG8_BAR; }
    }
    PG8_WAIT_V(0);
    if constexpr (!ALIGN_EPI) { if (wr == 0) PG8_BAR; }
    PG8_BAR;
    if constexpr (Epi::AFTER_DRAIN) { E.fused(acc, cur, wr, wc, fr, fq, lds, wid, lane); S.done(cur); }
#undef PG8_SA
#undef PG8_SB
#undef PG8_STAGE
#undef PG8_LDA
#undef PG8_LDB
#undef PG8_MMA
#undef PG8_WAIT_V
#undef PG8_WAIT_L
#undef PG8_BAR
#undef PG8_SCHED
}
}

#ifndef MK_N_LAUNCHES
#define MK_N_LAUNCHES 1
#endif
constexpr int N_LAUNCHES = MK_N_LAUNCHES;
constexpr int N_PHASES = 7;
constexpr int D = 1024, TSEQ = 2048, NB_P = 8, NB_S = 128;
constexpr int MP = NB_P * TSEQ;
constexpr int MTOT = MP + NB_S;
constexpr int MPAD = 16640;
constexpr int NPAD = 9472;
constexpr int C_LX = 0, C_LZ = 1024, C_SZ = 2048, C_XBC = 4096, C_MG = 7168, C_DT = 9216;
constexpr int NHEAD = 32;
constexpr float LN_EPS = 1e-5f, RMS_EPS = 1e-5f;
constexpr float ALPHA = 1.189207115002721f;
constexpr size_t O_Y = 0, O_LHP = 16908288, O_LCP = 16916480, O_SHP = 16941056, O_SCP = 19038208,
                 O_LHS = 19111936, O_LCS = 19243008, O_SHS = 19636224, O_SCS = 53190656, O_END = 54370304;
constexpr size_t MiB = 1u << 20;
constexpr size_t WS_CTL = 0, CTL_ZERO_BYTES = 64 * 1024;
constexpr size_t WS_MOD = 1 * MiB, WS_GWT = 3 * MiB, WS_DT = 4 * MiB, WS_SSQ = 7 * MiB, WS_WOUT = 10 * MiB, WS_WSSD = 12 * MiB, WS_WLRU = 16 * MiB,
                 WS_WIN = 18 * MiB, WS_H = 37 * MiB, WS_YSSD = 70 * MiB, WS_YLRU = 136 * MiB, WS_PROJ = 169 * MiB, WS_TBUF = 470 * MiB, WS_END = 503 * MiB;
static_assert(WS_WIN + (size_t)NPAD * 1024 * 2 <= WS_H && WS_H + (size_t)MPAD * 1024 * 2 <= WS_YSSD && WS_YSSD + (size_t)MPAD * 2048 * 2 <= WS_YLRU && WS_YLRU + (size_t)MPAD * 1024 * 2 <= WS_PROJ
              && WS_PROJ + (size_t)MPAD * NPAD * 2 <= WS_TBUF && WS_TBUF + (size_t)MPAD * 1024 * 2 <= WS_END, "ws map");
constexpr int LDS_BYTES = 155648;
constexpr int MISC_OFF = 155648 - 256;

#define LAS __attribute__((address_space(3)))
typedef unsigned short bf16_t;
typedef float f32x4 __attribute__((ext_vector_type(4)));
typedef float f32x2 __attribute__((ext_vector_type(2)));
typedef short bf16x8 __attribute__((ext_vector_type(8)));
typedef unsigned u32x4 __attribute__((ext_vector_type(4)));
typedef unsigned u32x2 __attribute__((ext_vector_type(2)));

__device__ __forceinline__ unsigned pk2(float lo, float hi) { return pg8::cvt_pk_bf16(lo, hi); }
__device__ __forceinline__ float bflo(unsigned w) { return __uint_as_float(w << 16); }
__device__ __forceinline__ float bfhi(unsigned w) { return __uint_as_float(w & 0xffff0000u); }
__device__ __forceinline__ float bf1(bf16_t v) { return __uint_as_float(((unsigned)v) << 16); }
__device__ __forceinline__ float fexp(float x) { return __builtin_amdgcn_exp2f(x * 1.4426950408889634f); }
__device__ __forceinline__ float frcp(float x) { return __builtin_amdgcn_rcpf(x); }
__device__ __forceinline__ float sigm(float x) { return frcp(1.f + fexp(-x)); }
__device__ __forceinline__ float silu(float x) { return x * sigm(x); }
__device__ __forceinline__ float softplus_acc(float x) { return fmaxf(x, 0.f) + log1pf(expf(-fabsf(x))); }
__device__ __forceinline__ float neg_expm1(float x) {
    const float p = -x * (1.f + x * (0.5f + x * (0.16666667f + x * (0.041666668f + x * (0.0083333338f + x * 0.0013888889f)))));
    const float q = 1.f - fexp(x);
    return x > -0.3f ? p : q;
}
__device__ __forceinline__ float wave_sum(float v) {
#pragma unroll
    for (int o = 1; o < 64; o <<= 1) v += __shfl_xor(v, o);
    return v;
}
#define LDS_WAIT() asm volatile("s_waitcnt lgkmcnt(0)" ::: "memory")
#define VM_WAIT() asm volatile("s_waitcnt vmcnt(0)" ::: "memory")
#define CFENCE() asm volatile("" ::: "memory")
#define LAUNDER(v) asm volatile("" : "+v"(v))

#define XB_TMO      128
#define XB_XCNT(j)  (256  + 64 * (j))
#define XB_XSUB(j)  (1280 + 64 * (j))
#define XB_XGEN(j)  (2304 + 64 * (j))
#define XB_TOP      3328
#define XB_TOPGEN   3392
#define XCD_BAR_WORDS 3456
#define XB_SPIN_CAP (1u << 18)
__device__ __forceinline__ unsigned xb_ld(unsigned* p)              { return __hip_atomic_load(p, __ATOMIC_RELAXED, __HIP_MEMORY_SCOPE_AGENT); }
__device__ __forceinline__ unsigned xb_add(unsigned* p, unsigned v) { return __hip_atomic_fetch_add(p, v, __ATOMIC_RELAXED, __HIP_MEMORY_SCOPE_AGENT); }
__device__ __forceinline__ unsigned xb_xcc_id() { return (unsigned)__builtin_amdgcn_s_getreg((3 << 11) | 20) & 0xFu; }
#define XB_SPIN(cond, bar) do { unsigned _sp = 0; while (cond) { __builtin_amdgcn_s_sleep(1); \
    if ((++_sp & 255u) == 0u) { if (xb_ld(&(bar)[XB_TMO])) break; if (_sp > XB_SPIN_CAP) { atomicAdd(&(bar)[XB_TMO], 1u); break; } } } } while (0)
struct XcdBarrier { unsigned* bar; unsigned x; volatile LAS unsigned* st; };
__device__ __forceinline__ XcdBarrier xcd_barrier_post(unsigned* bar, volatile LAS unsigned* st) {
    XcdBarrier b; b.bar = bar; b.x = xb_xcc_id(); b.st = st;
    if (threadIdx.x == 0) (void)xb_add(&bar[XB_XCNT(b.x)], 1u);
    return b;
}
__device__ __forceinline__ void xcd_barrier_complete(unsigned* bar, unsigned x, unsigned& nloc, unsigned& nx) {
    const unsigned G = gridDim.x * gridDim.y * gridDim.z;
    unsigned sum, cnt, mine, sp = 0u;
    for (;;) {
        sum = 0u; cnt = 0u; mine = 0u;
#pragma unroll
        for (unsigned j = 0; j < 16; ++j) { const unsigned c = xb_ld(&bar[XB_XCNT(j)]); sum += c; cnt += (c > 0u) ? 1u : 0u; mine = (j == x) ? c : mine; }
        if (sum == G) break;
        __builtin_amdgcn_s_sleep(1);
        if ((++sp & 255u) == 0u) { if (xb_ld(&bar[XB_TMO])) break; if (sp > XB_SPIN_CAP) { atomicAdd(&bar[XB_TMO], 1u); break; } }
    }
    nloc = mine > 0u ? mine : 1u; nx = cnt > 0u ? cnt : 1u;
}
__device__ __forceinline__ void xcd_barrier(const XcdBarrier& b) {
    asm volatile("s_waitcnt vmcnt(0)" ::: "memory");
    __syncthreads();
    if (threadIdx.x == 0) {
        unsigned* bar = b.bar;
        __builtin_amdgcn_s_waitcnt(0);
        unsigned nloc = b.st[0], nx = b.st[1];
        if (nloc == 0u) { xcd_barrier_complete(bar, b.x, nloc, nx); b.st[0] = nloc; b.st[1] = nx; }
        const unsigned old = xb_add(&bar[XB_XSUB(b.x)], 1u);
        const unsigned gen = old / nloc;
        if (old + 1u == (gen + 1u) * nloc) {
            __builtin_amdgcn_fence(__ATOMIC_RELEASE, "agent");
            asm volatile("s_waitcnt vmcnt(0)" ::: "memory");
            const unsigned og = xb_add(&bar[XB_TOP], 1u);
            const unsigned tg = og / nx;
            if (og + 1u == (tg + 1u) * nx) xb_add(&bar[XB_TOPGEN], 1u);
            else XB_SPIN(xb_ld(&bar[XB_TOPGEN]) == tg, bar);
            __builtin_amdgcn_fence(__ATOMIC_ACQUIRE, "agent");
            xb_add(&bar[XB_XGEN(b.x)], 1u);
            asm volatile("s_waitcnt vmcnt(0)" ::: "memory");
        } else {
            XB_SPIN(xb_ld(&bar[XB_XGEN(b.x)]) == gen, bar);
            __builtin_amdgcn_fence(__ATOMIC_ACQUIRE, "agent");
            asm volatile("s_waitcnt vmcnt(0)" ::: "memory");
        }
    }
    __syncthreads();
}

struct Args { const float* in[29]; float* out; unsigned char* ws; int ph_lo, ph_hi; };
enum { I_XP = 0, I_XS, I_SLH, I_SLC, I_SSH, I_SSC, I_CP, I_CS, I_WCOND, I_BCOND, I_WIN, I_LCW, I_LCB, I_LWA, I_LBA, I_LWX, I_LBX, I_LAM,
       I_SCW, I_SCB, I_DTB, I_ALOG, I_SD, I_NORMW, I_WLRU, I_WSSD, I_WOUT, I_LNG, I_LNB };

__device__ __forceinline__ void transpose_item(const float* W, int ldw, int k0, int n0, bf16_t* WT, int ldt, int drow0, int dcol0, const float* kscale, LAS float* scr, int lane) {
#pragma unroll 8
    for (int i = 0; i < 32; ++i) { const int kk = 2 * i + (lane >> 5); float v = W[(size_t)(k0 + kk) * ldw + n0 + (lane & 31)]; if (kscale) v *= kscale[k0 + kk]; scr[kk * 33 + (lane & 31)] = v; }
    LDS_WAIT();
    const int c = lane & 7;
#pragma unroll
    for (int j = 0; j < 4; ++j) { const int n = (lane >> 3) + 8 * j; const LAS float* s = scr + (8 * c) * 33 + n;
        u32x4 o; o.x = pk2(s[0 * 33], s[1 * 33]); o.y = pk2(s[2 * 33], s[3 * 33]); o.z = pk2(s[4 * 33], s[5 * 33]); o.w = pk2(s[6 * 33], s[7 * 33]);
        *(u32x4*)(WT + (size_t)(drow0 + n) * ldt + dcol0 + 8 * c) = o; }
    LDS_WAIT();
}

__device__ __forceinline__ void p0_mod(const Args& a, LAS unsigned char* lds, int blk) {
    const int tid = threadIdx.x, lane = tid & 63, wid = __builtin_amdgcn_readfirstlane(tid >> 6), fr = lane & 15, fq = lane >> 4;
    const float* wc = a.in[I_WCOND]; const int n0 = blk * 16;
    float* MOD = (float*)(a.ws + WS_MOD);
    f32x4 acc[9];
#pragma unroll
    for (int i = 0; i < 9; ++i) acc[i] = (f32x4){0.f, 0.f, 0.f, 0.f};
    for (int ks = 0; ks < 4; ++ks) {
        const int k0 = (wid * 4 + ks) * 32 + 8 * fq;
        float bv[8];
#pragma unroll
        for (int j = 0; j < 8; ++j) bv[j] = wc[(size_t)(k0 + j) * 3072 + n0 + fr];
        union { bf16x8 v; unsigned u[4]; } bfr;
#pragma unroll
        for (int j = 0; j < 4; ++j) bfr.u[j] = pk2(bv[2 * j], bv[2 * j + 1]);
#pragma unroll
        for (int rt = 0; rt < 9; ++rt) {
            int row = 16 * rt + fr; row = row > 135 ? 135 : row;
            const float* src = row < 8 ? a.in[I_CP] + (size_t)row * 1024 : a.in[I_CS] + (size_t)(row - 8) * 1024;
            const f32x4 lo = *(const f32x4*)(src + k0), hi = *(const f32x4*)(src + k0 + 4);
            union { bf16x8 v; unsigned u[4]; } afr;
            afr.u[0] = pk2(lo[0], lo[1]); afr.u[1] = pk2(lo[2], lo[3]); afr.u[2] = pk2(hi[0], hi[1]); afr.u[3] = pk2(hi[2], hi[3]);
            acc[rt] = __builtin_amdgcn_mfma_f32_16x16x32_bf16(afr.v, bfr.v, acc[rt], 0, 0, 0);
        }
    }
    LAS float* red = (LAS float*)lds;
#pragma unroll
    for (int rt = 0; rt < 9; ++rt) *(LAS f32x4*)(red + ((wid * 9 + rt) * 64 + lane) * 4) = acc[rt];
    __syncthreads();
    for (int idx = tid; idx < 9 * 256; idx += 512) {
        const int rt = idx >> 8, rem = idx & 255, ln = rem >> 2, r = rem & 3;
        float s = 0.f;
#pragma unroll
        for (int w = 0; w < 8; ++w) s += red[((w * 9 + rt) * 64 + ln) * 4 + r];
        const int row = 16 * rt + 4 * (ln >> 4) + r, n = n0 + (ln & 15);
        if (row < 136) MOD[(size_t)row * 3072 + n] = s + a.in[I_BCOND][n];
    }
    __syncthreads();
}

__device__ __forceinline__ void p0_prep(const Args& a, LAS unsigned char* lds) {
    const int tid = threadIdx.x, lane = tid & 63, wid = __builtin_amdgcn_readfirstlane(tid >> 6);
    const int G = gridDim.x;
    for (int blk = blockIdx.x; blk < 192; blk += G) p0_mod(a, lds, blk);
    LAS float* scr = (LAS float*)(lds + wid * 16384);
    bf16_t* WIN = (bf16_t*)(a.ws + WS_WIN); bf16_t* WSSD = (bf16_t*)(a.ws + WS_WSSD); bf16_t* WLRU = (bf16_t*)(a.ws + WS_WLRU); bf16_t* WOUT = (bf16_t*)(a.ws + WS_WOUT); bf16_t* GWT = (bf16_t*)(a.ws + WS_GWT);
    const int gw = blockIdx.x * 8 + wid, NGW = G * 8;
    constexpr int I_A = 16 * 289, I_B = 32 * 32, I_C = 16 * 32, I_D = 16 * 32, I_E = 64;
    for (int it = gw; it < I_A + I_B + I_C + I_D + I_E; it += NGW) {
        int r = it;
        if (r < I_A) { const int kb = r / 289, nb = r % 289, n0 = 32 * nb; const int drow = n0 < 7168 ? n0 : (n0 < 7200 ? C_DT : n0 - 32);
            transpose_item(a.in[I_WIN], 9248, 64 * kb, n0, WIN, 1024, drow, 64 * kb, nullptr, scr, lane); continue; } r -= I_A;
        if (r < I_B) { const int kb = r / 32, nb = r % 32; transpose_item(a.in[I_WSSD], 1024, 64 * kb, 32 * nb, WSSD, 2048, 32 * nb, 64 * kb, a.in[I_NORMW], scr, lane); continue; } r -= I_B;
        if (r < I_C) { const int kb = r / 32, nb = r % 32; transpose_item(a.in[I_WLRU], 1024, 64 * kb, 32 * nb, WLRU, 1024, 32 * nb, 64 * kb, nullptr, scr, lane); continue; } r -= I_C;
        if (r < I_D) { const int kb = r / 32, nb = r % 32; transpose_item(a.in[I_WOUT], 1024, 64 * kb, 32 * nb, WOUT, 1024, 32 * nb, 64 * kb, nullptr, scr, lane); continue; } r -= I_D;
        { const int gate = r >> 5, m = (r >> 1) & 15, nb = r & 1;
            transpose_item(a.in[gate ? I_LWX : I_LWA] + (size_t)m * 4096, 64, 0, 32 * nb, GWT + (size_t)m * 8192, 64, gate * 64 + 32 * nb, 0, nullptr, scr, lane); }
    }
}

__device__ __forceinline__ void p1_modulate(const Args& a) {
    const int tid = threadIdx.x, lane = tid & 63, wid = __builtin_amdgcn_readfirstlane(tid >> 6);
    const int gw = blockIdx.x * 8 + wid, NGW = gridDim.x * 8;
    const float* MOD = (const float*)(a.ws + WS_MOD); bf16_t* H = (bf16_t*)(a.ws + WS_H);
    for (int row = gw; row < MTOT; row += NGW) {
        const int bi = row < MP ? (row >> 11) : (8 + row - MP);
        const float* x = row < MP ? a.in[I_XP] + (size_t)row * D : a.in[I_XS] + (size_t)(row - MP) * D;
        const float* md = MOD + (size_t)bi * 3072;
#pragma unroll
        for (int j = 0; j < 4; ++j) { const int c = 4 * lane + 256 * j;
            const f32x4 xv = *(const f32x4*)(x + c), sh = *(const f32x4*)(md + c), sc = *(const f32x4*)(md + 1024 + c);
            const f32x4 v = xv * (sc + 1.0f) + sh;
            u32x2 o; o.x = pk2(v[0], v[1]); o.y = pk2(v[2], v[3]);
            *(u32x2*)(H + (size_t)row * D + c) = o; }
    }
}

struct EpiProj {
    static constexpr bool PERM = true, AFTER_DRAIN = false, HOOK = false;
    bf16_t* O; float* DT;
    __device__ __forceinline__ void hook(pg8::f32x4 (&)[2][2][4][2], const pg8::Unit&, int, int, int, int, int) const {}
    __device__ __forceinline__ void operator()(const pg8::f32x4 (&acc)[2][2][4][2], const pg8::Unit& u, int wr, int wc, int fr, int fq) const {
        const int row0 = u.pm * 256 + wr * 64 + fr, col0 = u.pn * 256 + wc * 32 + 8 * fq;
#pragma unroll
        for (int ai = 0; ai < 2; ++ai)
#pragma unroll
            for (int m = 0; m < 4; ++m) { const int row = row0 + ai * 128 + m * 16; bf16_t* rowp = O + (size_t)row * NPAD + col0;
#pragma unroll
                for (int bj = 0; bj < 2; ++bj) { const pg8::f32x4 v0 = acc[ai][bj][m][0], v1 = acc[ai][bj][m][1];
                    u32x4 w; w.x = pk2(v0[0], v0[1]); w.y = pk2(v0[2], v0[3]); w.z = pk2(v1[0], v1[1]); w.w = pk2(v1[2], v1[3]);
                    *(u32x4*)(rowp + bj * 128) = w; }
                if (u.pn == 36 && wc == 0) { float* dp = DT + (size_t)row * 32 + 8 * fq; *(f32x4*)dp = acc[ai][0][m][0]; *(f32x4*)(dp + 4) = acc[ai][0][m][1]; } }
    }
};

__device__ __forceinline__ void mul4_inplace(pg8::f32x4& v, float f) {
    float x0 = v[0], x1 = v[1], x2 = v[2], x3 = v[3];
    asm("v_mul_f32_e32 %0, %1, %0" : "+v"(x0) : "v"(f)); asm("v_mul_f32_e32 %0, %1, %0" : "+v"(x1) : "v"(f));
    asm("v_mul_f32_e32 %0, %1, %0" : "+v"(x2) : "v"(f)); asm("v_mul_f32_e32 %0, %1, %0" : "+v"(x3) : "v"(f));
    v[0] = x0; v[1] = x1; v[2] = x2; v[3] = x3;
}
struct EpiLruT {
    static constexpr bool PERM = true, AFTER_DRAIN = false, HOOK = false;
    bf16_t* T; const bf16_t* PROJ;
    __device__ __forceinline__ void hook(pg8::f32x4 (&)[2][2][4][2], const pg8::Unit&, int, int, int, int, int) const {}
    __device__ __forceinline__ void operator()(const pg8::f32x4 (&acc)[2][2][4][2], const pg8::Unit& u, int wr, int wc, int fr, int fq) const {
        const int row0 = u.pm * 256 + wr * 64 + fr, col0 = u.pn * 256 + wc * 32 + 8 * fq;
#pragma unroll
        for (int ai = 0; ai < 2; ++ai)
#pragma unroll
            for (int m = 0; m < 4; ++m) { const int row = row0 + ai * 128 + m * 16;
#pragma unroll
                for (int bj = 0; bj < 2; ++bj) { const u32x4 la = *(const u32x4*)(PROJ + (size_t)row * NPAD + C_MG + col0 + bj * 128);
                    const pg8::f32x4 v0 = acc[ai][bj][m][0], v1 = acc[ai][bj][m][1];
                    u32x4 w; w.x = pk2(v0[0] * sigm(bflo(la[0])), v0[1] * sigm(bfhi(la[0]))); w.y = pk2(v0[2] * sigm(bflo(la[1])), v0[3] * sigm(bfhi(la[1])));
                    w.z = pk2(v1[0] * sigm(bflo(la[2])), v1[1] * sigm(bfhi(la[2]))); w.w = pk2(v1[2] * sigm(bflo(la[3])), v1[3] * sigm(bfhi(la[3])));
                    *(u32x4*)(T + (size_t)row * D + col0 + bj * 128) = w; CFENCE(); } }
    }
};
struct EpiMerge {
#ifndef HOOK_ON
#define HOOK_ON true
#endif
    static constexpr bool PERM = true, AFTER_DRAIN = false, HOOK = HOOK_ON;
    bf16_t* O; const bf16_t* T; const bf16_t* PROJ; const float* SSQ;
    __device__ __forceinline__ float ms(const float* p) const { const f32x4 a = *(const f32x4*)p, b = *(const f32x4*)(p + 4); return ((a[0] + a[1]) + (a[2] + a[3]) + (b[0] + b[1]) + (b[2] + b[3])) * (1.0f / 512.0f) + RMS_EPS; }
    __device__ __forceinline__ void hook(pg8::f32x4 (&acc)[2][2][4][2], const pg8::Unit& u, int t, int wr, int wc, int fr, int fq) const {
        if (t > 24) return;
        LAUNDER(fr);
        const int row0 = u.pm * 256 + wr * 64 + fr;
        const int g = (t >> 3) - 1;
#pragma unroll
        for (int ai = 0; ai < 2; ++ai)
#pragma unroll
            for (int m = 0; m < 4; ++m) { const int row = row0 + ai * 128 + m * 16; const float* sp = SSQ + (size_t)row * 32 + 8 * g;
                const float f = sqrtf(ms(sp + 8) * frcp(ms(sp)));
#pragma unroll
                for (int bj = 0; bj < 2; ++bj)
#pragma unroll
                    for (int n = 0; n < 2; ++n) mul4_inplace(acc[ai][bj][m][n], f);
                CFENCE(); }
    }
    __device__ __forceinline__ void operator()(const pg8::f32x4 (&acc)[2][2][4][2], const pg8::Unit& u, int wr, int wc, int fr, int fq) const {
        const int row0 = u.pm * 256 + wr * 64 + fr, col0 = u.pn * 256 + wc * 32 + 8 * fq;
#pragma unroll
        for (int ai = 0; ai < 2; ++ai)
#pragma unroll
            for (int m = 0; m < 4; ++m) { const int row = row0 + ai * 128 + m * 16; const float rs3 = __builtin_amdgcn_rsqf(ms(SSQ + (size_t)row * 32 + 24));
#pragma unroll
                for (int bj = 0; bj < 2; ++bj) { const u32x4 lb = *(const u32x4*)(PROJ + (size_t)row * NPAD + C_MG + 1024 + col0 + bj * 128);
                    const u32x4 tv = *(const u32x4*)(T + (size_t)row * D + col0 + bj * 128);
                    const pg8::f32x4 v0 = acc[ai][bj][m][0] * rs3, v1 = acc[ai][bj][m][1] * rs3;
                    u32x4 w; w.x = pk2(bflo(tv[0]) + v0[0] * sigm(bflo(lb[0])), bfhi(tv[0]) + v0[1] * sigm(bfhi(lb[0]))); w.y = pk2(bflo(tv[1]) + v0[2] * sigm(bflo(lb[1])), bfhi(tv[1]) + v0[3] * sigm(bfhi(lb[1])));
                    w.z = pk2(bflo(tv[2]) + v1[0] * sigm(bflo(lb[2])), bfhi(tv[2]) + v1[1] * sigm(bfhi(lb[2]))); w.w = pk2(bflo(tv[3]) + v1[2] * sigm(bflo(lb[3])), bfhi(tv[3]) + v1[3] * sigm(bfhi(lb[3])));
                    *(u32x4*)(O + (size_t)row * D + col0 + bj * 128) = w; CFENCE(); } }
    }
};

struct EpiOut {
    static constexpr bool PERM = false, AFTER_DRAIN = false, HOOK = false;
    float* out; const float* xp; const float* xs; const float* MOD;
    __device__ __forceinline__ void hook(pg8::f32x4 (&)[2][2][4][2], const pg8::Unit&, int, int, int, int, int) const {}
    __device__ __forceinline__ void operator()(const pg8::f32x4 (&acc)[2][2][4][2], const pg8::Unit& u, int wr, int wc, int fr, int fq) const {
        const int row0 = u.pm * 256 + wr * 64 + fr, col0 = u.pn * 256 + wc * 32 + 4 * fq;
#pragma unroll
        for (int ai = 0; ai < 2; ++ai)
#pragma unroll
            for (int m = 0; m < 4; ++m) { const int row = row0 + ai * 128 + m * 16;
                if (row < MTOT) {
                    const int bi = row < MP ? (row >> 11) : (8 + row - MP);
                    const float* x = row < MP ? xp + (size_t)row * D : xs + (size_t)(row - MP) * D;
                    const float* gt = MOD + (size_t)bi * 3072 + 2048;
#pragma unroll
                    for (int bj = 0; bj < 2; ++bj)
#pragma unroll
                        for (int n = 0; n < 2; ++n) { const int c = col0 + bj * 128 + n * 16;
                            const f32x4 xv = *(const f32x4*)(x + c), gv = *(const f32x4*)(gt + c);
                            *(f32x4*)(out + (size_t)row * D + c) = xv * ALPHA + gv * acc[ai][bj][m][n]; } } }
    }
};

__device__ __forceinline__ bf16x8 ldfrag(const LAS unsigned char* base, int stride, int row0, int k0, int fr, int fq) {
    return *(const LAS bf16x8*)(base + (row0 + fr) * stride + (k0 + 8 * fq) * 2);
}
__device__ __forceinline__ float bfx(const u32x4& v, int e) { return (e & 1) ? bfhi(v[e >> 1]) : bflo(v[e >> 1]); }
__device__ __forceinline__ float bfx2(const u32x2& v, int e) { return (e & 1) ? bfhi(v[e >> 1]) : bflo(v[e >> 1]); }

template <class T> __device__ __forceinline__ T ldg(const void* ubase, size_t uoff, unsigned voff) { return *(const T*)((const char*)ubase + uoff + (size_t)voff); }
template <class T> __device__ __forceinline__ void stg(void* ubase, size_t uoff, unsigned voff, T v) { *(T*)((char*)ubase + uoff + (size_t)voff) = v; }

__device__ __forceinline__ void ssd_prompt_item(const Args& a, LAS unsigned char* lds, int b, int h) {
    const int wid = __builtin_amdgcn_readfirstlane(threadIdx.x >> 6);
    const int g = h >> 3;
    constexpr int RS = 272, MATB = 128 * RS, HALFB = 64 * RS;
    constexpr int O_CC = 0, O_BC = MATB, O_BCT = 2 * MATB, O_XST = 3 * MATB, O_HB = 3 * MATB + HALFB, O_TAB = 3 * MATB + 2 * HALFB;
    LAS float* tab = (LAS float*)(lds + O_TAB) + wid * 256;
    const bf16_t* PROJ = (const bf16_t*)(a.ws + WS_PROJ); const float* DT = (const float*)(a.ws + WS_DT);
    bf16_t* YSSD = (bf16_t*)(a.ws + WS_YSSD); float* SSQ = (float*)(a.ws + WS_SSQ);
    const float A_h = -expf(a.in[I_ALOG][h]), D_h = a.in[I_SD][h], dtb = a.in[I_DTB][h];
    const float* cw = a.in[I_SCW]; const float* cb = a.in[I_SCB];
    const int l0 = 16 * wid;
    f32x4 sacc[4];
#pragma unroll
    for (int i = 0; i < 4; ++i) sacc[i] = (f32x4){0.f, 0.f, 0.f, 0.f};

    for (int c = 0; c < 16; ++c) {
        const size_t R0 = (size_t)b * TSEQ + 128 * c;
        float acs_last;
        {
            int t_ = threadIdx.x; LAUNDER(t_); const int lane = t_ & 63;
            const unsigned voD = (unsigned)(lane * 32 + h) * 4u;
            float dt0 = ldg<float>(DT, R0 * 128, voD), dt1 = ldg<float>(DT, (R0 + 64) * 128, voD);
            dt0 = softplus_acc(dt0 + dtb); dt1 = softplus_acc(dt1 + dtb);
            float s0 = dt0 * A_h, s1 = dt1 * A_h;
#pragma unroll
            for (int o = 1; o < 64; o <<= 1) { const float t0 = __shfl_up(s0, o), t1 = __shfl_up(s1, o); if (lane >= o) { s0 += t0; s1 += t1; } }
            s1 += __shfl(s0, 63);
            acs_last = __shfl(s1, 63);
            tab[lane] = s0; tab[64 + lane] = s1; tab[128 + lane] = dt0; tab[192 + lane] = dt1;
            LDS_WAIT(); CFENCE();
        }
        {
            int t_ = threadIdx.x; LAUNDER(t_);
            const int mat = t_ >> 8, tg = (t_ & 255) >> 4, oc = t_ & 15;
            const int chBC = 2048 + mat * 512 + g * 128 + 8 * oc;
            const unsigned voBC = (unsigned)((8 * tg) * NPAD + C_XBC + chBC) * 2u;
            u32x4 rawBC[11];
#pragma unroll
            for (int i = 0; i < 11; ++i) { const int tok = 8 * tg - 3 + i;
                if (c == 0 && tok < 0) rawBC[i] = (u32x4){0u, 0u, 0u, 0u};
                else rawBC[i] = ldg<u32x4>(PROJ, (R0 + i - 3) * (size_t)(NPAD * 2), voBC); }
            LAS unsigned char* rowp = lds + (mat ? O_CC : O_BC) + (8 * tg) * RS + 16 * oc;
            LAS unsigned char* colp = lds + O_BCT + (8 * oc) * RS + 16 * tg;
            LAS float* tabp = tab + 8 * tg;
#pragma unroll
            for (int hc = 0; hc < 2; ++hc) {
                f32x4 w[4], bv;
#pragma unroll
                for (int k = 0; k < 4; ++k) w[k] = ldg<f32x4>(cw, (size_t)(k * 3072 + 4 * hc) * 4, (unsigned)chBC * 4u);
                bv = ldg<f32x4>(cb, (size_t)(4 * hc) * 4, (unsigned)chBC * 4u);
                float oprev[4]; unsigned colpk[4][4];
#pragma unroll
                for (int j = 0; j < 8; ++j) {
                    float o[4];
#pragma unroll
                    for (int e = 0; e < 4; ++e) {
                        const int ee = 4 * hc + e;
                        float v = bv[e] + w[0][e] * bfx(rawBC[j], ee) + w[1][e] * bfx(rawBC[j + 1], ee) + w[2][e] * bfx(rawBC[j + 2], ee) + w[3][e] * bfx(rawBC[j + 3], ee);
                        o[e] = silu(v); }
                    u32x2 rp; rp.x = pk2(o[0], o[1]); rp.y = pk2(o[2], o[3]);
                    *(LAS u32x2*)(rowp + j * RS + 8 * hc) = rp;
                    if (mat == 0) {
                        const float de = fexp(acs_last - tabp[j]);
#pragma unroll
                        for (int e = 0; e < 4; ++e) { const float sv = o[e] * de; if (j & 1) colpk[e][j >> 1] = pk2(oprev[e], sv); else oprev[e] = sv; }
                    }
                }
                if (mat == 0) {
#pragma unroll
                    for (int e = 0; e < 4; ++e) { u32x4 cp; cp.x = colpk[e][0]; cp.y = colpk[e][1]; cp.z = colpk[e][2]; cp.w = colpk[e][3];
                        *(LAS u32x4*)(colp + (4 * hc + e) * RS) = cp; }
                }
                CFENCE();
            }
        }
        {
            int t_ = threadIdx.x; LAUNDER(t_);
            const int tg4 = t_ >> 4, qc = t_ & 15;
            const int chX = h * 64 + 4 * qc;
            const unsigned voX = (unsigned)((4 * tg4) * NPAD + C_XBC + chX) * 2u;
            u32x2 rawX[7];
#pragma unroll
            for (int i = 0; i < 7; ++i) { const int tok = 4 * tg4 - 3 + i;
                if (c == 0 && tok < 0) rawX[i] = (u32x2){0u, 0u};
                else rawX[i] = ldg<u32x2>(PROJ, (R0 + i - 3) * (size_t)(NPAD * 2), voX); }
            f32x4 w[4], bv;
#pragma unroll
            for (int k = 0; k < 4; ++k) w[k] = ldg<f32x4>(cw, (size_t)(k * 3072) * 4, (unsigned)chX * 4u);
            bv = ldg<f32x4>(cb, 0, (unsigned)chX * 4u);
            const f32x4 dt4 = *(const LAS f32x4*)(tab + 128 + 4 * tg4);
            float o[4][4];
#pragma unroll
            for (int j = 0; j < 4; ++j)
#pragma unroll
                for (int e = 0; e < 4; ++e) {
                    float v = bv[e] + w[0][e] * bfx2(rawX[j], e) + w[1][e] * bfx2(rawX[j + 1], e) + w[2][e] * bfx2(rawX[j + 2], e) + w[3][e] * bfx2(rawX[j + 3], e);
                    o[j][e] = silu(v) * dt4[j]; }
            LAS unsigned char* xp = lds + O_XST + (4 * qc) * RS + 8 * tg4;
#pragma unroll
            for (int e = 0; e < 4; ++e) { u32x2 cp; cp.x = pk2(o[0][e], o[1][e]); cp.y = pk2(o[2][e], o[3][e]);
                *(LAS u32x2*)(xp + e * RS) = cp; }
        }
        __syncthreads();
        f32x4 yacc[4], cbv[8];
        {
            int t_ = threadIdx.x; LAUNDER(t_); const int lane = t_ & 63, fr = lane & 15, fq = lane >> 4;
            const LAS unsigned char* fb = lds + fr * RS + 16 * fq;
            bf16x8 cf[4];
#pragma unroll
            for (int k = 0; k < 4; ++k) cf[k] = *(const LAS bf16x8*)(fb + O_CC + l0 * RS + 64 * k);
#pragma unroll
            for (int i = 0; i < 4; ++i) yacc[i] = (f32x4){0.f, 0.f, 0.f, 0.f};
            if (c > 0) {
#pragma unroll
                for (int pt = 0; pt < 4; ++pt)
#pragma unroll
                    for (int k = 0; k < 4; ++k) yacc[pt] = __builtin_amdgcn_mfma_f32_16x16x32_bf16(*(const LAS bf16x8*)(fb + O_HB + 16 * pt * RS + 64 * k), cf[k], yacc[pt], 0, 0, 0);
                const float ea = fexp(tab[l0 + fr]);
#pragma unroll
                for (int pt = 0; pt < 4; ++pt) yacc[pt] *= ea;
            }
#pragma unroll
            for (int st = 0; st < 8; ++st) { cbv[st] = (f32x4){0.f, 0.f, 0.f, 0.f};
#pragma unroll
                for (int k = 0; k < 4; ++k) cbv[st] = __builtin_amdgcn_mfma_f32_16x16x32_bf16(*(const LAS bf16x8*)(fb + O_BC + 16 * st * RS + 64 * k), cf[k], cbv[st], 0, 0, 0); }
            const float dec = fexp(acs_last);
#pragma unroll
            for (int pt = 0; pt < 4; ++pt) sacc[pt] *= dec;
#pragma unroll
            for (int k = 0; k < 4; ++k) { const bf16x8 bt = *(const LAS bf16x8*)(fb + O_BCT + l0 * RS + 64 * k);
#pragma unroll
                for (int pt = 0; pt < 4; ++pt) sacc[pt] = __builtin_amdgcn_mfma_f32_16x16x32_bf16(bt, *(const LAS bf16x8*)(fb + O_XST + 16 * pt * RS + 64 * k), sacc[pt], 0, 0, 0); }
        }
        __syncthreads();
        {
            int t_ = threadIdx.x; LAUNDER(t_); const int lane = t_ & 63, fr = lane & 15, fq = lane >> 4;
            const int l = l0 + fr; const float acs_l = tab[l], dl = D_h * frcp(tab[128 + l]);
            LAS unsigned char* mrow = lds + O_BC + l * RS + 8 * fq;
#pragma unroll
            for (int st = 0; st < 8; ++st) { const f32x4 as = *(const LAS f32x4*)(tab + 16 * st + 4 * fq);
                float m[4];
#pragma unroll
                for (int r = 0; r < 4; ++r) { const int sidx = 16 * st + 4 * fq + r; float v = cbv[st][r] * fexp(acs_l - as[r]); v = (sidx <= l) ? v : 0.f; m[r] = (sidx == l) ? v + dl : v; }
                u32x2 mp; mp.x = pk2(m[0], m[1]); mp.y = pk2(m[2], m[3]);
                *(LAS u32x2*)(mrow + 32 * st) = mp; }
            LDS_WAIT(); CFENCE();
            const LAS unsigned char* fb = lds + fr * RS + 16 * fq;
            const int kmax = wid >> 1;
            for (int k = 0; k <= kmax; ++k) { const bf16x8 mf = *(const LAS bf16x8*)(fb + O_BC + l0 * RS + 64 * k);
#pragma unroll
                for (int pt = 0; pt < 4; ++pt) yacc[pt] = __builtin_amdgcn_mfma_f32_16x16x32_bf16(*(const LAS bf16x8*)(fb + O_XST + 16 * pt * RS + 64 * k), mf, yacc[pt], 0, 0, 0); }
            const unsigned voZ = (unsigned)(fr * NPAD + C_SZ + h * 64 + 4 * fq) * 2u;
            const unsigned voY = (unsigned)(fr * 2048 + h * 64 + 4 * fq) * 2u, voS = (unsigned)(fr * 32 + h) * 4u;
            float ss = 0.f;
#pragma unroll
            for (int pt = 0; pt < 4; ++pt) {
                const u32x2 zr = ldg<u32x2>(PROJ, (R0 + l0) * (size_t)(NPAD * 2) + 32 * pt, voZ);
                const float g0 = yacc[pt][0] * silu(bflo(zr[0])), g1 = yacc[pt][1] * silu(bfhi(zr[0])), g2 = yacc[pt][2] * silu(bflo(zr[1])), g3 = yacc[pt][3] * silu(bfhi(zr[1]));
                ss += (g0 * g0 + g1 * g1) + (g2 * g2 + g3 * g3);
                u32x2 o; o.x = pk2(g0, g1); o.y = pk2(g2, g3);
                stg<u32x2>(YSSD, (R0 + l0) * (size_t)(2048 * 2) + 32 * pt, voY, o); }
            ss += __shfl_xor(ss, 16); ss += __shfl_xor(ss, 32);
            if (fq == 0) stg<float>(SSQ, (R0 + l0) * 128, voS, ss);
        }
        __syncthreads();
        if (c < 15) {
            int t_ = threadIdx.x; LAUNDER(t_); const int lane = t_ & 63, fr = lane & 15, fq = lane >> 4;
            LAS unsigned char* hp = lds + O_HB + fr * RS + (l0 + 4 * fq) * 2;
#pragma unroll
            for (int pt = 0; pt < 4; ++pt) { u32x2 o; o.x = pk2(sacc[pt][0], sacc[pt][1]); o.y = pk2(sacc[pt][2], sacc[pt][3]);
                *(LAS u32x2*)(hp + 16 * pt * RS) = o; }
        }
    }
    {
        const int lane = threadIdx.x & 63, fr = lane & 15, fq = lane >> 4;
        float* so = a.out + O_SHP + ((size_t)(b * NHEAD + h) * 64) * 128;
#pragma unroll
        for (int pt = 0; pt < 4; ++pt) *(f32x4*)(so + (size_t)(16 * pt + fr) * 128 + l0 + 4 * fq) = sacc[pt];
    }
    __syncthreads();
}

__device__ __forceinline__ void lru_prompt_item(const Args& a, LAS unsigned char* lds, int b, int nb, int half) {
    const int tid = threadIdx.x, lane = tid & 63, wid = __builtin_amdgcn_readfirstlane(tid >> 6), fr = lane & 15, fq = lane >> 4;
    constexpr int US = 144;
    LAS unsigned char* ub = lds;
    LAS unsigned char* gwl = lds + 18432;
    LAS unsigned char* uf = lds + 27648;
    LAS float* tot = (LAS float*)(lds + 46080);
    const bf16_t* PROJ = (const bf16_t*)(a.ws + WS_PROJ); bf16_t* YLRU = (bf16_t*)(a.ws + WS_YLRU);
    const bf16_t* GWT = (const bf16_t*)(a.ws + WS_GWT) + (size_t)nb * 8192;
    { const int r = tid >> 3, ck = tid & 7; const int srow = r < 32 ? half * 32 + r : 64 + half * 32 + (r - 32);
        *(LAS u32x4*)(gwl + r * US + 16 * ck) = *(const u32x4*)(GWT + (size_t)srow * 64 + 8 * ck); }
    const int tg = tid >> 4, qc = tid & 15;
    const int chq = nb * 64 + 4 * qc;
    f32x4 cwv[4], cbv;
#pragma unroll
    for (int k = 0; k < 4; ++k) cwv[k] = *(const f32x4*)(a.in[I_LCW] + k * 1024 + chq);
    cbv = *(const f32x4*)(a.in[I_LCB] + chq);
    float ba[2], bx[2], cl[2], carry[2];
#pragma unroll
    for (int ci = 0; ci < 2; ++ci) { const int ch = nb * 64 + half * 32 + 16 * ci + fr; ba[ci] = a.in[I_LBA][ch]; bx[ci] = a.in[I_LBX][ch]; cl[ci] = -8.0f * softplus_acc(-a.in[I_LAM][ch]); carry[ci] = 0.f; }
    const int t0w = 16 * wid;
    for (int c = 0; c < 16; ++c) {
        const size_t R0 = (size_t)b * TSEQ + 128 * c;
        u32x2 raw[7];
#pragma unroll
        for (int i = 0; i < 7; ++i) { const int tok = 4 * tg - 3 + i;
            if (c == 0 && tok < 0) raw[i] = (u32x2){0u, 0u};
            else raw[i] = *(const u32x2*)(PROJ + (R0 + tok) * NPAD + C_LX + chq); }
        bf16_t zr[2][4];
#pragma unroll
        for (int ci = 0; ci < 2; ++ci)
#pragma unroll
            for (int r = 0; r < 4; ++r) zr[ci][r] = PROJ[(R0 + t0w + 4 * fq + r) * NPAD + C_LZ + nb * 64 + half * 32 + 16 * ci + fr];
        {
            float o[4][4];
#pragma unroll
            for (int j = 0; j < 4; ++j)
#pragma unroll
                for (int e = 0; e < 4; ++e) o[j][e] = cbv[e] + cwv[0][e] * bfx2(raw[j], e) + cwv[1][e] * bfx2(raw[j + 1], e) + cwv[2][e] * bfx2(raw[j + 2], e) + cwv[3][e] * bfx2(raw[j + 3], e);
#pragma unroll
            for (int j = 0; j < 4; ++j) { u32x2 p; p.x = pk2(o[j][0], o[j][1]); p.y = pk2(o[j][2], o[j][3]);
                *(LAS u32x2*)(ub + (4 * tg + j) * US + 8 * qc) = p;
                if ((qc >> 3) == half) *(LAS f32x4*)(uf + (4 * tg + j) * US + 16 * (qc & 7)) = (f32x4){o[j][0], o[j][1], o[j][2], o[j][3]}; }
        }
        __syncthreads();
        f32x4 ga[4];
#pragma unroll
        for (int jt = 0; jt < 4; ++jt) { ga[jt] = (f32x4){0.f, 0.f, 0.f, 0.f};
#pragma unroll
            for (int k = 0; k < 2; ++k) ga[jt] = __builtin_amdgcn_mfma_f32_16x16x32_bf16(ldfrag(ub, US, t0w, 32 * k, fr, fq), ldfrag(gwl, US, 16 * jt, 32 * k, fr, fq), ga[jt], 0, 0, 0); }
        float Ar[2][4], Br[2][4];
#pragma unroll
        for (int ci = 0; ci < 2; ++ci) {
            float Aacc = 1.f, Bacc = 0.f;
#pragma unroll
            for (int r = 0; r < 4; ++r) {
                const float u = *(const LAS float*)(uf + (t0w + 4 * fq + r) * US + 4 * (16 * ci + fr));
                const float rg = sigm(ga[ci][r] + ba[ci]), ig = sigm(ga[2 + ci][r] + bx[ci]);
                const float la = cl[ci] * rg, av = fexp(la);
                float mult = sqrtf(neg_expm1(2.0f * la));
                if (c == 0 && wid == 0 && fq == 0 && r == 0) mult = 1.0f;
                const float bb = mult * ig * u;
                Bacc = av * Bacc + bb; Aacc = av * Aacc; Ar[ci][r] = Aacc; Br[ci][r] = Bacc; }
        }
        float Ap[2], Bp[2];
#pragma unroll
        for (int ci = 0; ci < 2; ++ci) { Ap[ci] = 1.f; Bp[ci] = 0.f;
#pragma unroll
            for (int k = 0; k < 3; ++k) { const float Ak = __shfl(Ar[ci][3], 16 * k + fr), Bk = __shfl(Br[ci][3], 16 * k + fr); if (k < fq) { Bp[ci] = Ak * Bp[ci] + Bk; Ap[ci] = Ak * Ap[ci]; } }
            if (fq == 3) { LAS float* tp = tot + (((c & 1) * 8 + wid) * 32 + 16 * ci + fr) * 2; tp[0] = Ar[ci][3] * Ap[ci]; tp[1] = Ar[ci][3] * Bp[ci] + Br[ci][3]; } }
        __syncthreads();
#pragma unroll
        for (int ci = 0; ci < 2; ++ci) {
            float hin = carry[ci], hw = 0.f;
#pragma unroll
            for (int w = 0; w < 8; ++w) { const LAS float* tp = tot + (((c & 1) * 8 + w) * 32 + 16 * ci + fr) * 2; if (w == wid) hw = hin; hin = tp[0] * hin + tp[1]; }
            carry[ci] = hin;
            const float hs = Ap[ci] * hw + Bp[ci];
            const int ch = half * 32 + 16 * ci + fr;
#pragma unroll
            for (int r = 0; r < 4; ++r) { const float hv = Ar[ci][r] * hs + Br[ci][r];
                const float y = hv * silu(bf1(zr[ci][r]));
                YLRU[(R0 + t0w + 4 * fq + r) * 1024 + nb * 64 + ch] = (bf16_t)(pk2(y, 0.f) & 0xffffu); }
        }
    }
    if (wid == 0 && fq == 0) {
#pragma unroll
        for (int ci = 0; ci < 2; ++ci) a.out[O_LHP + (size_t)b * 1024 + nb * 64 + half * 32 + 16 * ci + fr] = carry[ci];
    }
    __syncthreads();
}

__device__ __forceinline__ void ssd_sample_item(const Args& a, LAS unsigned char* lds, int b, int h) {
    const int tid = threadIdx.x, lane = tid & 63;
    const int g = h >> 3; const size_t row = (size_t)MP + b;
    LAS float* sv = (LAS float*)lds;
    LAS float* sg = sv + 384;
    const bf16_t* PROJ = (const bf16_t*)(a.ws + WS_PROJ); bf16_t* YSSD = (bf16_t*)(a.ws + WS_YSSD);
    if (tid < 320) {
        const int cch = tid < 64 ? h * 64 + tid : (tid < 192 ? 2048 + g * 128 + (tid - 64) : 2560 + g * 128 + (tid - 192));
        const float* buf = a.in[I_SSC] + (size_t)b * 3 * 3072 + cch; const float* cw = a.in[I_SCW] + cch;
        float v = a.in[I_SCB][cch] + cw[0] * buf[0] + cw[3072] * buf[3072] + cw[2 * 3072] * buf[2 * 3072] + cw[3 * 3072] * bf1(PROJ[row * NPAD + C_XBC + cch]);
        sv[tid] = silu(v);
    } else if (tid < 384) sv[tid] = bf1(PROJ[row * NPAD + C_SZ + h * 64 + (tid - 320)]);
    const float dts = softplus_acc(((const float*)(a.ws + WS_DT))[row * 32 + h] + a.in[I_DTB][h]);
    const float dA = expf(dts * -expf(a.in[I_ALOG][h])), D_h = a.in[I_SD][h];
    __syncthreads();
    const int l32 = tid & 31, prow = tid >> 5, n0 = 4 * l32;
    const float* hin = a.in[I_SSH] + ((size_t)(b * NHEAD + h) * 64) * 128; float* hout = a.out + O_SHS + ((size_t)(b * NHEAD + h) * 64) * 128;
    const f32x4 Bv = *(const LAS f32x4*)(sv + 64 + n0), Cv = *(const LAS f32x4*)(sv + 192 + n0);
    f32x4 h0[4];
#pragma unroll
    for (int ps = 0; ps < 4; ++ps) h0[ps] = *(const f32x4*)(hin + (size_t)(ps * 16 + prow) * 128 + n0);
#pragma unroll
    for (int ps = 0; ps < 4; ++ps) { const int pp = ps * 16 + prow; const float xv = sv[pp], xdt = dts * xv;
        const f32x4 hn = h0[ps] * dA + Bv * xdt;
        *(f32x4*)(hout + (size_t)pp * 128 + n0) = hn;
        float part = (hn[0] * Cv[0] + hn[1] * Cv[1]) + (hn[2] * Cv[2] + hn[3] * Cv[3]);
#pragma unroll
        for (int o = 1; o < 32; o <<= 1) part += __shfl_xor(part, o);
        if (l32 == 0) { const float y = part + D_h * xv; const float gv = y * silu(sv[320 + pp]);
            YSSD[row * 2048 + h * 64 + pp] = (bf16_t)(pk2(gv, 0.f) & 0xffffu); sg[pp] = gv * gv; } }
    __syncthreads();
    if (tid < 64) { const float s = wave_sum(sg[lane]); if (lane == 0) ((float*)(a.ws + WS_SSQ))[row * 32 + h] = s; }
    __syncthreads();
}

__device__ __forceinline__ void lru_sample_item(const Args& a, int b, int nb, int lane) {
    const int ch = nb * 64 + lane; const size_t row = (size_t)MP + b;
    const bf16_t* PROJ = (const bf16_t*)(a.ws + WS_PROJ); bf16_t* YLRU = (bf16_t*)(a.ws + WS_YLRU);
    const float* buf = a.in[I_SLC] + (size_t)b * 3 * 1024 + ch; const float* cw = a.in[I_LCW] + ch;
    const float px = bf1(PROJ[row * NPAD + C_LX + ch]);
    const float b0 = buf[0], b1 = buf[1024], b2 = buf[2048];
    const float u = a.in[I_LCB][ch] + cw[0] * b0 + cw[1024] * b1 + cw[2048] * b2 + cw[3072] * px;
    float gr = a.in[I_LBA][ch], gi = a.in[I_LBX][ch];
    const float* wa = a.in[I_LWA] + (size_t)nb * 4096 + lane; const float* wx = a.in[I_LWX] + (size_t)nb * 4096 + lane;
#pragma unroll 8
    for (int k = 0; k < 64; ++k) { const float uk = __shfl(u, k); gr += uk * wa[k * 64]; gi += uk * wx[k * 64]; }
    const float rg = sigm(gr), ig = sigm(gi);
    const float la = -8.0f * softplus_acc(-a.in[I_LAM][ch]) * rg, av = fexp(la), mult = sqrtf(neg_expm1(2.0f * la));
    const float hv = av * a.in[I_SLH][(size_t)b * 1024 + ch] + mult * ig * u;
    a.out[O_LHS + (size_t)b * 1024 + ch] = hv;
    const float y = hv * silu(bf1(PROJ[row * NPAD + C_LZ + ch]));
    YLRU[row * 1024 + ch] = (bf16_t)(pk2(y, 0.f) & 0xffffu);
    float* lc = a.out + O_LCS + (size_t)b * 3 * 1024 + ch; lc[0] = b1; lc[1024] = b2; lc[2048] = px;
}

__device__ __forceinline__ void p3_mixers(const Args& a, LAS unsigned char* lds) {
    const int tid = threadIdx.x, lane = tid & 63, wid = __builtin_amdgcn_readfirstlane(tid >> 6);
    const int G = gridDim.x, bx = blockIdx.x;
#ifndef P3_SUB
#define P3_SUB 31
#endif
    if (P3_SUB & 1) for (int it = bx; it < 256; it += G) { const int xcd = it & 7, slot = it >> 3, pair = xcd * 4 + (slot >> 3); ssd_prompt_item(a, lds, pair >> 2, (pair & 3) * 8 + (slot & 7)); }
    if (P3_SUB & 2) for (int it = bx; it < 256; it += G) lru_prompt_item(a, lds, it >> 5, (it >> 1) & 15, it & 1);
    if (P3_SUB & 4) for (int it = bx; it < NB_S * NHEAD; it += G) ssd_sample_item(a, lds, it >> 5, it & 31);
    const int gw = bx * 8 + wid, NGW = G * 8;
    if (P3_SUB & 8) for (int it = gw; it < NB_S * 16; it += NGW) lru_sample_item(a, it >> 4, it & 15, lane);
    if (!(P3_SUB & 16)) return;
    const bf16_t* PROJ = (const bf16_t*)(a.ws + WS_PROJ);
    const int gt = bx * 512 + tid, NGT = G * 512;
    for (int i = gt; i < NB_P * 3 * 1024; i += NGT) { const int bb = i / 3072, j = (i / 1024) % 3, c = i & 1023; a.out[O_LCP + i] = bf1(PROJ[((size_t)bb * TSEQ + 2045 + j) * NPAD + C_LX + c]); }
    for (int i = gt; i < NB_P * 3 * 3072; i += NGT) { const int bb = i / 9216, j = (i / 3072) % 3, c = i % 3072; a.out[O_SCP + i] = bf1(PROJ[((size_t)bb * TSEQ + 2045 + j) * NPAD + C_XBC + c]); }
    for (int i = gt; i < NB_S * 3 * 3072; i += NGT) { const int bb = i / 9216, j = (i / 3072) % 3, c = i % 3072;
        a.out[O_SCS + i] = j < 2 ? a.in[I_SSC][(size_t)bb * 9216 + (j + 1) * 3072 + c] : bf1(PROJ[((size_t)MP + bb) * NPAD + C_XBC + c]); }
}

__device__ __forceinline__ void p6_layernorm(const Args& a) {
    const int tid = threadIdx.x, lane = tid & 63, wid = __builtin_amdgcn_readfirstlane(tid >> 6);
    const int gw = blockIdx.x * 8 + wid, NGW = gridDim.x * 8;
    const float* lg = a.in[I_LNG]; const float* lb = a.in[I_LNB];
    for (int row = gw; row < MTOT; row += NGW) {
        float* p = a.out + (size_t)row * D;
        f32x4 v[4]; float s = 0.f;
#pragma unroll
        for (int j = 0; j < 4; ++j) { v[j] = *(const f32x4*)(p + 4 * lane + 256 * j); s += (v[j][0] + v[j][1]) + (v[j][2] + v[j][3]); }
        const float mean = wave_sum(s) * (1.f / D); float s2 = 0.f;
#pragma unroll
        for (int j = 0; j < 4; ++j) { v[j] = v[j] - mean; s2 += (v[j][0] * v[j][0] + v[j][1] * v[j][1]) + (v[j][2] * v[j][2] + v[j][3] * v[j][3]); }
        const float rstd = __builtin_amdgcn_rsqf(wave_sum(s2) * (1.f / D) + LN_EPS);
#pragma unroll
        for (int j = 0; j < 4; ++j) { const int c = 4 * lane + 256 * j; const f32x4 gv = *(const f32x4*)(lg + c), bv = *(const f32x4*)(lb + c);
            *(f32x4*)(p + c) = v[j] * rstd * gv + bv; }
    }
}

__global__ void __launch_bounds__(512, 2) fwd(Args args) {
    extern __shared__ __attribute__((aligned(16))) unsigned char lds_raw[];
    LAS unsigned char* lds = (LAS unsigned char*)lds_raw;
    volatile LAS unsigned* MISC = (volatile LAS unsigned*)(lds + MISC_OFF);
    const int tid = threadIdx.x;
    if (tid < 64) MISC[tid] = 0u;
    __syncthreads();
    unsigned* ctl = (unsigned*)(args.ws + WS_CTL);
    XcdBarrier bar; bar.bar = ctl + 1024; bar.x = 0; bar.st = nullptr;
    if (N_LAUNCHES == 1) bar = xcd_barrier_post(ctl + 1024, MISC + 8);
    const int lo = args.ph_lo, hi = args.ph_hi;
#ifndef ONLY_PHASE
#define ONLY_PHASE -1
#endif
#define IN(k) ((ONLY_PHASE < 0 || ONLY_PHASE == (k)) && lo <= (k) && (k) < hi)
#define SEAM(k) do { if (IN(k) && IN((k) + 1)) xcd_barrier(bar); } while (0)
    const int G = gridDim.x;
    if (IN(0)) { p0_prep(args, lds); } SEAM(0);
    if (IN(1)) { p1_modulate(args); } SEAM(1);
    if (IN(2)) {
        pg8::Gemm g{(const pg8::bf16_t*)(args.ws + WS_H), (const pg8::bf16_t*)(args.ws + WS_WIN), MPAD, NPAD, 1024};
        pg8::StaticOrder S; S.init(MPAD, NPAD, G, (int)blockIdx.x);
        EpiProj E{(bf16_t*)(args.ws + WS_PROJ), (float*)(args.ws + WS_DT)};
        pg8::gemm_phase<EpiProj, pg8::StaticOrder, true, true>(lds, g, S, E);
    } SEAM(2);
    if (IN(3)) { p3_mixers(args, lds); } SEAM(3);
    if (IN(4)) {
        pg8::StaticOrder S; S.init(MPAD, 1024, G, (int)blockIdx.x);
        { pg8::Gemm g{(const pg8::bf16_t*)(args.ws + WS_YLRU), (const pg8::bf16_t*)(args.ws + WS_WLRU), MPAD, 1024, 1024};
          EpiLruT E{(bf16_t*)(args.ws + WS_TBUF), (const bf16_t*)(args.ws + WS_PROJ)};
          pg8::gemm_phase<EpiLruT, pg8::StaticOrder, true, true>(lds, g, S, E); }
        VM_WAIT(); __syncthreads();
        { pg8::Gemm g{(const pg8::bf16_t*)(args.ws + WS_YSSD), (const pg8::bf16_t*)(args.ws + WS_WSSD), MPAD, 1024, 2048};
          EpiMerge E{(bf16_t*)(args.ws + WS_H), (const bf16_t*)(args.ws + WS_TBUF), (const bf16_t*)(args.ws + WS_PROJ), (const float*)(args.ws + WS_SSQ)};
          pg8::gemm_phase<EpiMerge, pg8::StaticOrder, true, true>(lds, g, S, E); }
    } SEAM(4);
    if (IN(5)) {
        pg8::Gemm g{(const pg8::bf16_t*)(args.ws + WS_H), (const pg8::bf16_t*)(args.ws + WS_WOUT), MPAD, 1024, 1024};
        pg8::StaticOrder S; S.init(MPAD, 1024, G, (int)blockIdx.x);
        EpiOut E{args.out, args.in[I_XP], args.in[I_XS], (const float*)(args.ws + WS_MOD)};
        pg8::gemm_phase<EpiOut, pg8::StaticOrder, true, true>(lds, g, S, E);
    } SEAM(5);
    if (IN(6)) { p6_layernorm(args); }
#undef IN
#undef SEAM
}

extern "C" void kernel_launch(void* const* d_in, const int* in_sizes, int n_in, void* d_out, int out_size, void* d_ws, size_t ws_size, hipStream_t stream) {
    static int grid = 0;
    if (grid == 0) {
        if (n_in != 29 || (size_t)out_size != O_END || ws_size < WS_END) { fprintf(stderr, "kernel_launch: unexpected shapes: n_in %d out %d ws %zu (need %zu)\n", n_in, out_size, ws_size, (size_t)WS_END); grid = -1; return; }
        int dev = 0, cus = 0, per_cu = 0;
        if (hipGetDevice(&dev) != hipSuccess || hipDeviceGetAttribute(&cus, hipDeviceAttributeMultiprocessorCount, dev) != hipSuccess) { grid = -1; return; }
        if (hipFuncSetAttribute((const void*)fwd, hipFuncAttributeMaxDynamicSharedMemorySize, LDS_BYTES) != hipSuccess) { fprintf(stderr, "kernel_launch: hipFuncSetAttribute failed\n"); grid = -1; return; }
        if (hipOccupancyMaxActiveBlocksPerMultiprocessor(&per_cu, (const void*)fwd, 512, LDS_BYTES) != hipSuccess || per_cu < 1) { fprintf(stderr, "kernel_launch: occupancy query says %d blocks per CU\n", per_cu); (void)hipGetLastError(); per_cu = 1; }
        grid = cus;
    }
    if (grid < 0) return;
    (void)hipMemsetAsync((char*)d_ws + WS_CTL, 0, CTL_ZERO_BYTES, stream);
    Args a{};
    for (int i = 0; i < 29; ++i) a.in[i] = (const float*)d_in[i];
    a.out = (float*)d_out; a.ws = (unsigned char*)d_ws;
    if (N_LAUNCHES == 1) {
        a.ph_lo = 0; a.ph_hi = N_PHASES;
        void* kargs[] = {&a};
        hipError_t e = hipLaunchCooperativeKernel((const void*)fwd, dim3(grid), dim3(512), kargs, LDS_BYTES, stream);
        if (e != hipSuccess) fprintf(stderr, "kernel_launch: cooperative launch failed: %s (grid %d)\n", hipGetErrorString(e), grid);
    } else {
        for (int ph = 0; ph < N_PHASES; ++ph) { a.ph_lo = ph; a.ph_hi = ph + 1; hipLaunchKernelGGL(fwd, dim3(grid), dim3(512), LDS_BYTES, stream, a); }
    }
}
```

```cpp
#include <hip/hip_runtime.h>
#include <cstdio>
#include <cstdint>
namespace pg8 {
#define PG8_LAS __attribute__((address_space(3)))
typedef unsigned short bf16_t;
typedef short bf16x8 __attribute__((ext_vector_type(8)));
typedef float f32x4 __attribute__((ext_vector_type(4)));
typedef unsigned u32x4 __attribute__((ext_vector_type(4)));
constexpr int BM = 256, BK = 64, HALF = 128, HTB = HALF * BK * 2  , STAGE_BYTES = 8 * HTB, NXCD = 8, WGM = 8;

__host__ __device__ __forceinline__ int lds_byte(int r, int c) { const int st = (r >> 4) * 2 + (c >> 5), rr = r & 15, cc = c & 31, ob = rr * 64 + cc * 2; return st * 1024 + (ob ^ (((ob >> 9) & 1) << 5)); }
__host__ __device__ __forceinline__ void stage_rc(int b, int& R, int& C) { const int st = b / 1024, sb = b % 1024, swz = sb ^ (((sb >> 9) & 1) << 5); R = (st >> 1) * 16 + swz / 64; C = (st & 1) * 32 + (swz % 64) / 2; }
__host__ __device__ __forceinline__ int perm32(int rho) { const int n = rho >> 4, i = rho & 15; return 8 * (i >> 2) + 4 * n + (i & 3); }

struct Unit { int pm, pn; };
struct Gemm { const bf16_t* A; const bf16_t* Bt; int M, N, K; };

struct StaticOrder {
    int nM, nN, nwg, G, c;
    __host__ __device__ void init(int M, int N, int G_, int c_) { nM = M / BM; nN = N / BM; nwg = nM * nN; G = G_; c = c_; }
    __host__ __device__ bool next(int i, Unit& u) const {
        const long L = (long)i * G + c; if (L >= nwg) return false;
        int wgid = (int)L; { const int q = nwg / NXCD, r = nwg % NXCD, xcd = wgid % NXCD, off = wgid / NXCD; wgid = (xcd < r ? xcd * (q + 1) : r * (q + 1) + (xcd - r) * q) + off; }
        const int nig = WGM * nN, gid = wgid / nig, fm = gid * WGM, gsz = (nM - fm) < WGM ? (nM - fm) : WGM;
        u.pm = fm + ((wgid % nig) % gsz); u.pn = (wgid % nig) / gsz; return true;
    }
    __device__ __forceinline__ void a_ready(const Unit&) const {}
    __device__ __forceinline__ void done(const Unit&) const {}
};
__device__ __forceinline__ unsigned cvt_pk_bf16(float lo, float hi) { unsigned r; asm volatile("v_cvt_pk_bf16_f32 %0, %1, %2" : "=v"(r) : "v"(lo), "v"(hi)); return r; }
template <class Epi, class Sched, bool ALIGN_EPI = false, bool SP2 = false>
__device__ __forceinline__ void gemm_phase(PG8_LAS unsigned char* lds, const Gemm g, const Sched& S, const Epi& E) {
    const int tid = threadIdx.x, wid = __builtin_amdgcn_readfirstlane(tid >> 6), lane = tid & 63, wr = wid >> 2, wc = wid & 3, fr = lane & 15, fq = lane >> 4;
    const int K = g.K, nt = K / BK;
    unsigned voffA[2], voffB[2];
#pragma unroll
    for (int i = 0; i < 2; ++i) { int R, C; stage_rc(tid * 16 + i * 8192, R, C); const int Rb = Epi::PERM ? ((R & ~31) + perm32(R & 31)) : R;
        voffA[i] = (unsigned)(R * K + C) * 2u; voffB[i] = (unsigned)(Rb * K + C) * 2u; }
    const size_t kstep = (size_t)(BK * 2);
    const size_t hstep = (size_t)HALF * K * 2;
    const size_t tstep = 2 * hstep;
    const unsigned ldsw = (unsigned)wid * 1024u;
    const int aoff = lds_byte(wr * 64 + fr, fq * 8), boff = lds_byte(wc * 32 + fr, fq * 8);
#define PG8_SA(b, h) (((b) * 2 + (h)) * HTB)
#define PG8_SB(b, h) ((4 + (b) * 2 + (h)) * HTB)
#define PG8_STAGE(bufoff, gbase, voff) do { _Pragma("unroll") for (int _i = 0; _i < 2; ++_i) \
        __builtin_amdgcn_global_load_lds((const unsigned*)((const char*)(gbase) + (voff)[_i]), (PG8_LAS unsigned*)(lds + (bufoff) + ldsw + _i * 8192), 16, 0, 0); } while (0)
#define PG8_LDA(dst, b, h) do { _Pragma("unroll") for (int m = 0; m < 4; ++m) _Pragma("unroll") for (int k = 0; k < 2; ++k) dst[m][k] = *(const PG8_LAS bf16x8*)(lds + PG8_SA(b, h) + aoff + m * 2048 + k * 1024); } while (0)
#define PG8_LDB(dst, b, h) do { _Pragma("unroll") for (int n = 0; n < 2; ++n) _Pragma("unroll") for (int k = 0; k < 2; ++k) dst[n][k] = *(const PG8_LAS bf16x8*)(lds + PG8_SB(b, h) + boff + n * 2048 + k * 1024); } while (0)
#define PG8_MMA(ai, bj, At, Bt) do { __builtin_amdgcn_s_setprio(1); _Pragma("unroll") for (int m = 0; m < 4; ++m) _Pragma("unroll") for (int n = 0; n < 2; ++n) _Pragma("unroll") for (int k = 0; k < 2; ++k) \
        acc[ai][bj][m][n] = __builtin_amdgcn_mfma_f32_16x16x32_bf16(Bt[n][k], At[m][k], acc[ai][bj][m][n], 0, 0, 0); __builtin_amdgcn_s_setprio(0); } while (0)
#define PG8_WAIT_V(n) asm volatile("s_waitcnt vmcnt(" #n ")" ::: "memory")
#define PG8_WAIT_L(n) asm volatile("s_waitcnt lgkmcnt(" #n ")" ::: "memory")
#define PG8_BAR __builtin_amdgcn_s_barrier()
#define PG8_SCHED __builtin_amdgcn_sched_barrier(0)
    Unit cur, nxt; int ui = 0;
    if (!S.next(0, cur)) return;
    f32x4 acc[2][2][4][2];
#pragma unroll
    for (int a = 0; a < 2; ++a)
#pragma unroll
        for (int b = 0; b < 2; ++b)
#pragma unroll
            for (int m = 0; m < 4; ++m)
#pragma unroll
                for (int n = 0; n < 2; ++n) acc[a][b][m][n] = (f32x4){0.f, 0.f, 0.f, 0.f};
    bf16x8 At[4][2], B0[2][2], B1[2][2];
    const char* cA = (const char*)g.A + (size_t)cur.pm * tstep; const char* cB = (const char*)g.Bt + (size_t)cur.pn * tstep;
    S.a_ready(cur);
    if constexpr (SP2) {
        PG8_STAGE(PG8_SB(0, 0), cB, voffB); PG8_STAGE(PG8_SB(0, 1), cB + hstep, voffB); PG8_STAGE(PG8_SA(0, 0), cA, voffA); PG8_STAGE(PG8_SA(0, 1), cA + hstep, voffA);
        if (wr == 1) PG8_BAR;
        PG8_WAIT_V(2); PG8_BAR;
        PG8_STAGE(PG8_SB(1, 0), cB + kstep, voffB); PG8_STAGE(PG8_SA(1, 0), cA + kstep, voffA); PG8_STAGE(PG8_SB(1, 1), cB + hstep + kstep, voffB);
        PG8_WAIT_V(6); PG8_BAR;
    } else {
        PG8_STAGE(PG8_SB(0, 0), cB, voffB); PG8_STAGE(PG8_SA(0, 0), cA, voffA); PG8_STAGE(PG8_SB(0, 1), cB + hstep, voffB); PG8_STAGE(PG8_SA(0, 1), cA + hstep, voffA);
        if (wr == 1) PG8_BAR;
        PG8_WAIT_V(4); PG8_BAR;
        PG8_STAGE(PG8_SB(1, 0), cB + kstep, voffB); PG8_STAGE(PG8_SA(1, 0), cA + kstep, voffA); PG8_STAGE(PG8_SB(1, 1), cB + hstep + kstep, voffB);
        PG8_WAIT_V(6); PG8_BAR;
    }
    for (;;) {
        const bool has_next = S.next(ui + 1, nxt);
        const char* nA = has_next ? (const char*)g.A + (size_t)nxt.pm * tstep : cA; const char* nB = has_next ? (const char*)g.Bt + (size_t)nxt.pn * tstep : cB;
        for (int t = 0; t < nt; t += 2) {
            const bool last = (t == nt - 2);
            const char* a1 = cA + (size_t)(t + 1) * kstep;
            const char* a2 = last ? nA : cA + (size_t)(t + 2) * kstep; const char* b2 = last ? nB : cB + (size_t)(t + 2) * kstep;
            const char* a3 = a2 + kstep; const char* b3 = b2 + kstep;
            if (last && has_next) S.a_ready(nxt);
            if constexpr (Epi::HOOK) { if (t >= 8 && t <= 32 && (t & 7) == 0) E.hook(acc, cur, t, wr, wc, fr, fq); }
            if constexpr (SP2) {
            PG8_LDB(B0, 0, 0); PG8_LDB(B1, 0, 1); PG8_SCHED; PG8_LDA(At, 0, 0); PG8_STAGE(PG8_SA(1, 1), a1 + hstep, voffA);
            PG8_WAIT_V(8); PG8_WAIT_L(0); PG8_BAR; PG8_MMA(0, 0, At, B0); PG8_MMA(0, 1, At, B1); PG8_BAR; PG8_SCHED;
            PG8_LDA(At, 0, 1); PG8_STAGE(PG8_SB(0, 0), b2, voffB); PG8_STAGE(PG8_SB(0, 1), b2 + hstep, voffB); PG8_STAGE(PG8_SA(0, 0), a2, voffA);
            PG8_WAIT_V(8); PG8_WAIT_L(0); PG8_BAR; PG8_MMA(1, 0, At, B0); PG8_MMA(1, 1, At, B1); PG8_BAR; PG8_SCHED;
            PG8_LDB(B0, 1, 0); PG8_LDB(B1, 1, 1); PG8_SCHED; PG8_LDA(At, 1, 0); PG8_STAGE(PG8_SA(0, 1), a2 + hstep, voffA);
            PG8_WAIT_V(8); PG8_WAIT_L(0); PG8_BAR; PG8_MMA(0, 0, At, B0); PG8_MMA(0, 1, At, B1); PG8_BAR; PG8_SCHED;
            PG8_LDA(At, 1, 1); PG8_STAGE(PG8_SB(1, 0), b3, voffB); PG8_STAGE(PG8_SB(1, 1), b3 + hstep, voffB); PG8_STAGE(PG8_SA(1, 0), a3, voffA);
            PG8_WAIT_V(8); PG8_WAIT_L(0); PG8_BAR; PG8_MMA(1, 0, At, B0); PG8_MMA(1, 1, At, B1); PG8_BAR; PG8_SCHED;
            } else {
            PG8_LDB(B0, 0, 0); PG8_SCHED; PG8_LDA(At, 0, 0); PG8_STAGE(PG8_SA(1, 1), a1 + hstep, voffA);
            PG8_WAIT_L(8); PG8_BAR; PG8_WAIT_L(0); PG8_MMA(0, 0, At, B0); PG8_BAR; PG8_SCHED;
            PG8_LDB(B1, 0, 1); PG8_STAGE(PG8_SB(0, 0), b2, voffB);
            PG8_BAR; PG8_WAIT_L(0); PG8_MMA(0, 1, At, B1); PG8_BAR;
            PG8_LDA(At, 0, 1); PG8_STAGE(PG8_SA(0, 0), a2, voffA);
            PG8_BAR; PG8_WAIT_L(0); PG8_MMA(1, 0, At, B0); PG8_BAR; PG8_SCHED;
            PG8_STAGE(PG8_SB(0, 1), b2 + hstep, voffB);
            PG8_WAIT_V(6); PG8_BAR; PG8_MMA(1, 1, At, B1); PG8_BAR;
            PG8_LDB(B0, 1, 0); PG8_SCHED; PG8_LDA(At, 1, 0); PG8_STAGE(PG8_SA(0, 1), a2 + hstep, voffA);
            PG8_WAIT_L(8); PG8_BAR; PG8_WAIT_L(0); PG8_MMA(0, 0, At, B0); PG8_BAR; PG8_SCHED;
            PG8_LDB(B1, 1, 1); PG8_STAGE(PG8_SB(1, 0), b3, voffB);
            PG8_BAR; PG8_WAIT_L(0); PG8_MMA(0, 1, At, B1); PG8_BAR;
            PG8_LDA(At, 1, 1); PG8_STAGE(PG8_SA(1, 0), a3, voffA);
            PG8_BAR; PG8_WAIT_L(0); PG8_MMA(1, 0, At, B0); PG8_BAR; PG8_SCHED;
            PG8_STAGE(PG8_SB(1, 1), b3 + hstep, voffB);
            PG8_WAIT_V(6); PG8_BAR; PG8_MMA(1, 1, At, B1); PG8_BAR;
            }
        }
        if constexpr (ALIGN_EPI) { if (wr == 0) PG8_BAR; }
        if constexpr (!Epi::AFTER_DRAIN) { E(acc, cur, wr, wc, fr, fq); S.done(cur); }
        if (!has_next) break;
#pragma unroll
        for (int a = 0; a < 2; ++a)
#pragma unroll
            for (int b = 0; b < 2; ++b)
#pragma unroll
                for (int m = 0; m < 4; ++m)
#pragma unroll
                    for (int n = 0; n < 2; ++n) acc[a][b][m][n] = (f32x4){0.f, 0.f, 0.f, 0.f};
        cur = nxt; cA = nA; cB = nB; ++ui;
        if constexpr (ALIGN_EPI) { if (wr == 1) PG8_BAR; }
    }
    PG8_WAIT_V(0);
    if constexpr (!ALIGN_EPI) { if (wr == 0) PG8_BAR; }
    PG8_BAR;
    if constexpr (Epi::AFTER_DRAIN) { E.fused(acc, cur, wr, wc, fr, fq, lds, wid, lane); S.done(cur); }
#undef PG8_SA
#undef PG8_SB
#undef PG8_STAGE
#undef PG8_LDA
#undef PG8_LDB
#undef PG8_MMA
#undef PG8_WAIT_V
#undef PG8_WAIT_L
#undef PG8_BAR
#undef PG8_SCHED
}
}

#ifndef MK_N_LAUNCHES
#define MK_N_LAUNCHES 1
#endif
constexpr int N_LAUNCHES = MK_N_LAUNCHES;
constexpr int N_PHASES = 7;
constexpr int D = 1024, TSEQ = 2048, NB_P = 8, NB_S = 128;
constexpr int MP = NB_P * TSEQ;
constexpr int MTOT = MP + NB_S;
constexpr int MPAD = 16640;
constexpr int NPAD = 9472;
constexpr int C_LX = 0, C_LZ = 1024, C_SZ = 2048, C_XBC = 4096, C_MG = 7168, C_DT = 9216;
constexpr int NHEAD = 32;
constexpr float LN_EPS = 1e-5f, RMS_EPS = 1e-5f;
constexpr float ALPHA = 1.189207115002721f;
constexpr size_t O_Y = 0, O_LHP = 16908288, O_LCP = 16916480, O_SHP = 16941056, O_SCP = 19038208,
                 O_LHS = 19111936, O_LCS = 19243008, O_SHS = 19636224, O_SCS = 53190656, O_END = 54370304;
constexpr size_t MiB = 1u << 20;
constexpr size_t WS_CTL = 0, CTL_ZERO_BYTES = 64 * 1024;
constexpr size_t WS_MOD = 1 * MiB, WS_GWT = 3 * MiB, WS_DT = 4 * MiB, WS_SSQ = 7 * MiB, WS_WOUT = 10 * MiB, WS_WSSD = 12 * MiB, WS_WLRU = 16 * MiB,
                 WS_WIN = 18 * MiB, WS_H = 37 * MiB, WS_YSSD = 70 * MiB, WS_YLRU = 136 * MiB, WS_PROJ = 169 * MiB, WS_TBUF = 470 * MiB, WS_END = 503 * MiB;
static_assert(WS_WIN + (size_t)NPAD * 1024 * 2 <= WS_H && WS_H + (size_t)MPAD * 1024 * 2 <= WS_YSSD && WS_YSSD + (size_t)MPAD * 2048 * 2 <= WS_YLRU && WS_YLRU + (size_t)MPAD * 1024 * 2 <= WS_PROJ
              && WS_PROJ + (size_t)MPAD * NPAD * 2 <= WS_TBUF && WS_TBUF + (size_t)MPAD * 1024 * 2 <= WS_END, "ws map");
constexpr int LDS_BYTES = 155648;
constexpr int MISC_OFF = 155648 - 256;

#define LAS __attribute__((address_space(3)))
typedef unsigned short bf16_t;
typedef float f32x4 __attribute__((ext_vector_type(4)));
typedef float f32x2 __attribute__((ext_vector_type(2)));
typedef short bf16x8 __attribute__((ext_vector_type(8)));
typedef unsigned u32x4 __attribute__((ext_vector_type(4)));
typedef unsigned u32x2 __attribute__((ext_vector_type(2)));

__device__ __forceinline__ unsigned pk2(float lo, float hi) { return pg8::cvt_pk_bf16(lo, hi); }
__device__ __forceinline__ float bflo(unsigned w) { return __uint_as_float(w << 16); }
__device__ __forceinline__ float bfhi(unsigned w) { return __uint_as_float(w & 0xffff0000u); }
__device__ __forceinline__ float bf1(bf16_t v) { return __uint_as_float(((unsigned)v) << 16); }
__device__ __forceinline__ float fexp(float x) { return __builtin_amdgcn_exp2f(x * 1.4426950408889634f); }
__device__ __forceinline__ float frcp(float x) { return __builtin_amdgcn_rcpf(x); }
__device__ __forceinline__ float sigm(float x) { return frcp(1.f + fexp(-x)); }
__device__ __forceinline__ float silu(float x) { return x * sigm(x); }
__device__ __forceinline__ float softplus_acc(float x) { return fmaxf(x, 0.f) + log1pf(expf(-fabsf(x))); }
__device__ __forceinline__ float neg_expm1(float x) {
    const float p = -x * (1.f + x * (0.5f + x * (0.16666667f + x * (0.041666668f + x * (0.0083333338f + x * 0.0013888889f)))));
    const float q = 1.f - fexp(x);
    return x > -0.3f ? p : q;
}
__device__ __forceinline__ float wave_sum(float v) {
#pragma unroll
    for (int o = 1; o < 64; o <<= 1) v += __shfl_xor(v, o);
    return v;
}
#define LDS_WAIT() asm volatile("s_waitcnt lgkmcnt(0)" ::: "memory")
#define VM_WAIT() asm volatile("s_waitcnt vmcnt(0)" ::: "memory")
#define CFENCE() asm volatile("" ::: "memory")
#define LAUNDER(v) asm volatile("" : "+v"(v))

#define XB_TMO      128
#define XB_XCNT(j)  (256  + 64 * (j))
#define XB_XSUB(j)  (1280 + 64 * (j))
#define XB_XGEN(j)  (2304 + 64 * (j))
#define XB_TOP      3328
#define XB_TOPGEN   3392
#define XCD_BAR_WORDS 3456
#define XB_SPIN_CAP (1u << 18)
__device__ __forceinline__ unsigned xb_ld(unsigned* p)              { return __hip_atomic_load(p, __ATOMIC_RELAXED, __HIP_MEMORY_SCOPE_AGENT); }
__device__ __forceinline__ unsigned xb_add(unsigned* p, unsigned v) { return __hip_atomic_fetch_add(p, v, __ATOMIC_RELAXED, __HIP_MEMORY_SCOPE_AGENT); }
__device__ __forceinline__ unsigned xb_xcc_id() { return (unsigned)__builtin_amdgcn_s_getreg((3 << 11) | 20) & 0xFu; }
#define XB_SPIN(cond, bar) do { unsigned _sp = 0; while (cond) { __builtin_amdgcn_s_sleep(1); \
    if ((++_sp & 255u) == 0u) { if (xb_ld(&(bar)[XB_TMO])) break; if (_sp > XB_SPIN_CAP) { atomicAdd(&(bar)[XB_TMO], 1u); break; } } } } while (0)
struct XcdBarrier { unsigned* bar; unsigned x; volatile LAS unsigned* st; };
__device__ __forceinline__ XcdBarrier xcd_barrier_post(unsigned* bar, volatile LAS unsigned* st) {
    XcdBarrier b; b.bar = bar; b.x = xb_xcc_id(); b.st = st;
    if (threadIdx.x == 0) (void)xb_add(&bar[XB_XCNT(b.x)], 1u);
    return b;
}
__device__ __forceinline__ void xcd_barrier_complete(unsigned* bar, unsigned x, unsigned& nloc, unsigned& nx) {
    const unsigned G = gridDim.x * gridDim.y * gridDim.z;
    unsigned sum, cnt, mine, sp = 0u;
    for (;;) {
        sum = 0u; cnt = 0u; mine = 0u;
#pragma unroll
        for (unsigned j = 0; j < 16; ++j) { const unsigned c = xb_ld(&bar[XB_XCNT(j)]); sum += c; cnt += (c > 0u) ? 1u : 0u; mine = (j == x) ? c : mine; }
        if (sum == G) break;
        __builtin_amdgcn_s_sleep(1);
        if ((++sp & 255u) == 0u) { if (xb_ld(&bar[XB_TMO])) break; if (sp > XB_SPIN_CAP) { atomicAdd(&bar[XB_TMO], 1u); break; } }
    }
    nloc = mine > 0u ? mine : 1u; nx = cnt > 0u ? cnt : 1u;
}
__device__ __forceinline__ void xcd_barrier(const XcdBarrier& b) {
    asm volatile("s_waitcnt vmcnt(0)" ::: "memory");
    __syncthreads();
    if (threadIdx.x == 0) {
        unsigned* bar = b.bar;
        __builtin_amdgcn_s_waitcnt(0);
        unsigned nloc = b.st[0], nx = b.st[1];
        if (nloc == 0u) { xcd_barrier_complete(bar, b.x, nloc, nx); b.st[0] = nloc; b.st[1] = nx; }
        const unsigned old = xb_add(&bar[XB_XSUB(b.x)], 1u);
        const unsigned gen = old / nloc;
        if (old + 1u == (gen + 1u) * nloc) {
            __builtin_amdgcn_fence(__ATOMIC_RELEASE, "agent");
            asm volatile("s_waitcnt vmcnt(0)" ::: "memory");
            const unsigned og = xb_add(&bar[XB_TOP], 1u);
            const unsigned tg = og / nx;
            if (og + 1u == (tg + 1u) * nx) xb_add(&bar[XB_TOPGEN], 1u);
            else XB_SPIN(xb_ld(&bar[XB_TOPGEN]) == tg, bar);
            __builtin_amdgcn_fence(__ATOMIC_ACQUIRE, "agent");
            xb_add(&bar[XB_XGEN(b.x)], 1u);
            asm volatile("s_waitcnt vmcnt(0)" ::: "memory");
        } else {
            XB_SPIN(xb_ld(&bar[XB_XGEN(b.x)]) == gen, bar);
            __builtin_amdgcn_fence(__ATOMIC_ACQUIRE, "agent");
            asm volatile("s_waitcnt vmcnt(0)" ::: "memory");
        }
    }
    __syncthreads();
}

struct Args { const float* in[29]; float* out; unsigned char* ws; int ph_lo, ph_hi; };
enum { I_XP = 0, I_XS, I_SLH, I_SLC, I_SSH, I_SSC, I_CP, I_CS, I_WCOND, I_BCOND, I_WIN, I_LCW, I_LCB, I_LWA, I_LBA, I_LWX, I_LBX, I_LAM,
       I_SCW, I_SCB, I_DTB, I_ALOG, I_SD, I_NORMW, I_WLRU, I_WSSD, I_WOUT, I_LNG, I_LNB };

__device__ __forceinline__ void transpose_item(const float* W, int ldw, int k0, int n0, bf16_t* WT, int ldt, int drow0, int dcol0, const float* kscale, LAS float* scr, int lane) {
#pragma unroll 8
    for (int i = 0; i < 32; ++i) { const int kk = 2 * i + (lane >> 5); float v = W[(size_t)(k0 + kk) * ldw + n0 + (lane & 31)]; if (kscale) v *= kscale[k0 + kk]; scr[kk * 33 + (lane & 31)] = v; }
    LDS_WAIT();
    const int c = lane & 7;
#pragma unroll
    for (int j = 0; j < 4; ++j) { const int n = (lane >> 3) + 8 * j; const LAS float* s = scr + (8 * c) * 33 + n;
        u32x4 o; o.x = pk2(s[0 * 33], s[1 * 33]); o.y = pk2(s[2 * 33], s[3 * 33]); o.z = pk2(s[4 * 33], s[5 * 33]); o.w = pk2(s[6 * 33], s[7 * 33]);
        *(u32x4*)(WT + (size_t)(drow0 + n) * ldt + dcol0 + 8 * c) = o; }
    LDS_WAIT();
}

__device__ __forceinline__ void p0_mod(const Args& a, LAS unsigned char* lds, int blk) {
    const int tid = threadIdx.x, lane = tid & 63, wid = __builtin_amdgcn_readfirstlane(tid >> 6), fr = lane & 15, fq = lane >> 4;
    const float* wc = a.in[I_WCOND]; const int n0 = blk * 16;
    float* MOD = (float*)(a.ws + WS_MOD);
    f32x4 acc[9];
#pragma unroll
    for (int i = 0; i < 9; ++i) acc[i] = (f32x4){0.f, 0.f, 0.f, 0.f};
    for (int ks = 0; ks < 4; ++ks) {
        const int k0 = (wid * 4 + ks) * 32 + 8 * fq;
        float bv[8];
#pragma unroll
        for (int j = 0; j < 8; ++j) bv[j] = wc[(size_t)(k0 + j) * 3072 + n0 + fr];
        union { bf16x8 v; unsigned u[4]; } bfr;
#pragma unroll
        for (int j = 0; j < 4; ++j) bfr.u[j] = pk2(bv[2 * j], bv[2 * j + 1]);
#pragma unroll
        for (int rt = 0; rt < 9; ++rt) {
            int row = 16 * rt + fr; row = row > 135 ? 135 : row;
            const float* src = row < 8 ? a.in[I_CP] + (size_t)row * 1024 : a.in[I_CS] + (size_t)(row - 8) * 1024;
            const f32x4 lo = *(const f32x4*)(src + k0), hi = *(const f32x4*)(src + k0 + 4);
            union { bf16x8 v; unsigned u[4]; } afr;
            afr.u[0] = pk2(lo[0], lo[1]); afr.u[1] = pk2(lo[2], lo[3]); afr.u[2] = pk2(hi[0], hi[1]); afr.u[3] = pk2(hi[2], hi[3]);
            acc[rt] = __builtin_amdgcn_mfma_f32_16x16x32_bf16(afr.v, bfr.v, acc[rt], 0, 0, 0);
        }
    }
    LAS float* red = (LAS float*)lds;
#pragma unroll
    for (int rt = 0; rt < 9; ++rt) *(LAS f32x4*)(red + ((wid * 9 + rt) * 64 + lane) * 4) = acc[rt];
    __syncthreads();
    for (int idx = tid; idx < 9 * 256; idx += 512) {
        const int rt = idx >> 8, rem = idx & 255, ln = rem >> 2, r = rem & 3;
        float s = 0.f;
#pragma unroll
        for (int w = 0; w < 8; ++w) s += red[((w * 9 + rt) * 64 + ln) * 4 + r];
        const int row = 16 * rt + 4 * (ln >> 4) + r, n = n0 + (ln & 15);
        if (row < 136) MOD[(size_t)row * 3072 + n] = s + a.in[I_BCOND][n];
    }
    __syncthreads();
}

__device__ __forceinline__ void p0_prep(const Args& a, LAS unsigned char* lds) {
    const int tid = threadIdx.x, lane = tid & 63, wid = __builtin_amdgcn_readfirstlane(tid >> 6);
    const int G = gridDim.x;
    for (int blk = blockIdx.x; blk < 192; blk += G) p0_mod(a, lds, blk);
    LAS float* scr = (LAS float*)(lds + wid * 16384);
    bf16_t* WIN = (bf16_t*)(a.ws + WS_WIN); bf16_t* WSSD = (bf16_t*)(a.ws + WS_WSSD); bf16_t* WLRU = (bf16_t*)(a.ws + WS_WLRU); bf16_t* WOUT = (bf16_t*)(a.ws + WS_WOUT); bf16_t* GWT = (bf16_t*)(a.ws + WS_GWT);
    const int gw = blockIdx.x * 8 + wid, NGW = G * 8;
    constexpr int I_A = 16 * 289, I_B = 32 * 32, I_C = 16 * 32, I_D = 16 * 32, I_E = 64;
    for (int it = gw; it < I_A + I_B + I_C + I_D + I_E; it += NGW) {
        int r = it;
        if (r < I_A) { const int kb = r / 289, nb = r % 289, n0 = 32 * nb; const int drow = n0 < 7168 ? n0 : (n0 < 7200 ? C_DT : n0 - 32);
            transpose_item(a.in[I_WIN], 9248, 64 * kb, n0, WIN, 1024, drow, 64 * kb, nullptr, scr, lane); continue; } r -= I_A;
        if (r < I_B) { const int kb = r / 32, nb = r % 32; transpose_item(a.in[I_WSSD], 1024, 64 * kb, 32 * nb, WSSD, 2048, 32 * nb, 64 * kb, a.in[I_NORMW], scr, lane); continue; } r -= I_B;
        if (r < I_C) { const int kb = r / 32, nb = r % 32; transpose_item(a.in[I_WLRU], 1024, 64 * kb, 32 * nb, WLRU, 1024, 32 * nb, 64 * kb, nullptr, scr, lane); continue; } r -= I_C;
        if (r < I_D) { const int kb = r / 32, nb = r % 32; transpose_item(a.in[I_WOUT], 1024, 64 * kb, 32 * nb, WOUT, 1024, 32 * nb, 64 * kb, nullptr, scr, lane); continue; } r -= I_D;
        { const int gate = r >> 5, m = (r >> 1) & 15, nb = r & 1;
            transpose_item(a.in[gate ? I_LWX : I_LWA] + (size_t)m * 4096, 64, 0, 32 * nb, GWT + (size_t)m * 8192, 64, gate * 64 + 32 * nb, 0, nullptr, scr, lane); }
    }
}

__device__ __forceinline__ void p1_modulate(const Args& a) {
    const int tid = threadIdx.x, lane = tid & 63, wid = __builtin_amdgcn_readfirstlane(tid >> 6);
    const int gw = blockIdx.x * 8 + wid, NGW = gridDim.x * 8;
    const float* MOD = (const float*)(a.ws + WS_MOD); bf16_t* H = (bf16_t*)(a.ws + WS_H);
    for (int row = gw; row < MTOT; row += NGW) {
        const int bi = row < MP ? (row >> 11) : (8 + row - MP);
        const float* x = row < MP ? a.in[I_XP] + (size_t)row * D : a.in[I_XS] + (size_t)(row - MP) * D;
        const float* md = MOD + (size_t)bi * 3072;
#pragma unroll
        for (int j = 0; j < 4; ++j) { const int c = 4 * lane + 256 * j;
            const f32x4 xv = *(const f32x4*)(x + c), sh = *(const f32x4*)(md + c), sc = *(const f32x4*)(md + 1024 + c);
            const f32x4 v = xv * (sc + 1.0f) + sh;
            u32x2 o; o.x = pk2(v[0], v[1]); o.y = pk2(v[2], v[3]);
            *(u32x2*)(H + (size_t)row * D + c) = o; }
    }
}

struct EpiProj {
    static constexpr bool PERM = true, AFTER_DRAIN = false, HOOK = false;
    bf16_t* O; float* DT;
    __device__ __forceinline__ void hook(pg8::f32x4 (&)[2][2][4][2], const pg8::Unit&, int, int, int, int, int) const {}
    __device__ __forceinline__ void operator()(const pg8::f32x4 (&acc)[2][2][4][2], const pg8::Unit& u, int wr, int wc, int fr, int fq) const {
        const int row0 = u.pm * 256 + wr * 64 + fr, col0 = u.pn * 256 + wc * 32 + 8 * fq;
#pragma unroll
        for (int ai = 0; ai < 2; ++ai)
#pragma unroll
            for (int m = 0; m < 4; ++m) { const int row = row0 + ai * 128 + m * 16; bf16_t* rowp = O + (size_t)row * NPAD + col0;
#pragma unroll
                for (int bj = 0; bj < 2; ++bj) { const pg8::f32x4 v0 = acc[ai][bj][m][0], v1 = acc[ai][bj][m][1];
                    u32x4 w; w.x = pk2(v0[0], v0[1]); w.y = pk2(v0[2], v0[3]); w.z = pk2(v1[0], v1[1]); w.w = pk2(v1[2], v1[3]);
                    *(u32x4*)(rowp + bj * 128) = w; }
                if (u.pn == 36 && wc == 0) { float* dp = DT + (size_t)row * 32 + 8 * fq; *(f32x4*)dp = acc[ai][0][m][0]; *(f32x4*)(dp + 4) = acc[ai][0][m][1]; } }
    }
};

__device__ __forceinline__ void mul4_inplace(pg8::f32x4& v, float f) {
    float x0 = v[0], x1 = v[1], x2 = v[2], x3 = v[3];
    asm("v_mul_f32_e32 %0, %1, %0" : "+v"(x0) : "v"(f)); asm("v_mul_f32_e32 %0, %1, %0" : "+v"(x1) : "v"(f));
    asm("v_mul_f32_e32 %0, %1, %0" : "+v"(x2) : "v"(f)); asm("v_mul_f32_e32 %0, %1, %0" : "+v"(x3) : "v"(f));
    v[0] = x0; v[1] = x1; v[2] = x2; v[3] = x3;
}
struct EpiLruT {
    static constexpr bool PERM = true, AFTER_DRAIN = false, HOOK = false;
    bf16_t* T; const bf16_t* PROJ;
    __device__ __forceinline__ void hook(pg8::f32x4 (&)[2][2][4][2], const pg8::Unit&, int, int, int, int, int) const {}
    __device__ __forceinline__ void operator()(const pg8::f32x4 (&acc)[2][2][4][2], const pg8::Unit& u, int wr, int wc, int fr, int fq) const {
        const int row0 = u.pm * 256 + wr * 64 + fr, col0 = u.pn * 256 + wc * 32 + 8 * fq;
#pragma unroll
        for (int ai = 0; ai < 2; ++ai)
#pragma unroll
            for (int m = 0; m < 4; ++m) { const int row = row0 + ai * 128 + m * 16;
#pragma unroll
                for (int bj = 0; bj < 2; ++bj) { const u32x4 la = *(const u32x4*)(PROJ + (size_t)row * NPAD + C_MG + col0 + bj * 128);
                    const pg8::f32x4 v0 = acc[ai][bj][m][0], v1 = acc[ai][bj][m][1];
                    u32x4 w; w.x = pk2(v0[0] * sigm(bflo(la[0])), v0[1] * sigm(bfhi(la[0]))); w.y = pk2(v0[2] * sigm(bflo(la[1])), v0[3] * sigm(bfhi(la[1])));
                    w.z = pk2(v1[0] * sigm(bflo(la[2])), v1[1] * sigm(bfhi(la[2]))); w.w = pk2(v1[2] * sigm(bflo(la[3])), v1[3] * sigm(bfhi(la[3])));
                    *(u32x4*)(T + (size_t)row * D + col0 + bj * 128) = w; CFENCE(); } }
    }
};
struct EpiMerge {
#ifndef HOOK_ON
#define HOOK_ON true
#endif
    static constexpr bool PERM = true, AFTER_DRAIN = false, HOOK = HOOK_ON;
    bf16_t* O; const bf16_t* T; const bf16_t* PROJ; const float* SSQ;
    __device__ __forceinline__ float ms(const float* p) const { const f32x4 a = *(const f32x4*)p, b = *(const f32x4*)(p + 4); return ((a[0] + a[1]) + (a[2] + a[3]) + (b[0] + b[1]) + (b[2] + b[3])) * (1.0f / 512.0f) + RMS_EPS; }
    __device__ __forceinline__ void hook(pg8::f32x4 (&acc)[2][2][4][2], const pg8::Unit& u, int t, int wr, int wc, int fr, int fq) const {
        if (t > 24) return;
        LAUNDER(fr);
        const int row0 = u.pm * 256 + wr * 64 + fr;
        const int g = (t >> 3) - 1;
#pragma unroll
        for (int ai = 0; ai < 2; ++ai)
#pragma unroll
            for (int m = 0; m < 4; ++m) { const int row = row0 + ai * 128 + m * 16; const float* sp = SSQ + (size_t)row * 32 + 8 * g;
                const float f = sqrtf(ms(sp + 8) * frcp(ms(sp)));
#pragma unroll
                for (int bj = 0; bj < 2; ++bj)
#pragma unroll
                    for (int n = 0; n < 2; ++n) mul4_inplace(acc[ai][bj][m][n], f);
                CFENCE(); }
    }
    __device__ __forceinline__ void operator()(const pg8::f32x4 (&acc)[2][2][4][2], const pg8::Unit& u, int wr, int wc, int fr, int fq) const {
        const int row0 = u.pm * 256 + wr * 64 + fr, col0 = u.pn * 256 + wc * 32 + 8 * fq;
#pragma unroll
        for (int ai = 0; ai < 2; ++ai)
#pragma unroll
            for (int m = 0; m < 4; ++m) { const int row = row0 + ai * 128 + m * 16; const float rs3 = __builtin_amdgcn_rsqf(ms(SSQ + (size_t)row * 32 + 24));
#pragma unroll
                for (int bj = 0; bj < 2; ++bj) { const u32x4 lb = *(const u32x4*)(PROJ + (size_t)row * NPAD + C_MG + 1024 + col0 + bj * 128);
                    const u32x4 tv = *(const u32x4*)(T + (size_t)row * D + col0 + bj * 128);
                    const pg8::f32x4 v0 = acc[ai][bj][m][0] * rs3, v1 = acc[ai][bj][m][1] * rs3;
                    u32x4 w; w.x = pk2(bflo(tv[0]) + v0[0] * sigm(bflo(lb[0])), bfhi(tv[0]) + v0[1] * sigm(bfhi(lb[0]))); w.y = pk2(bflo(tv[1]) + v0[2] * sigm(bflo(lb[1])), bfhi(tv[1]) + v0[3] * sigm(bfhi(lb[1])));
                    w.z = pk2(bflo(tv[2]) + v1[0] * sigm(bflo(lb[2])), bfhi(tv[2]) + v1[1] * sigm(bfhi(lb[2]))); w.w = pk2(bflo(tv[3]) + v1[2] * sigm(bflo(lb[3])), bfhi(tv[3]) + v1[3] * sigm(bfhi(lb[3])));
                    *(u32x4*)(O + (size_t)row * D + col0 + bj * 128) = w; CFENCE(); } }
    }
};

struct EpiOut {
    static constexpr bool PERM = false, AFTER_DRAIN = false, HOOK = false;
    float* out; const float* xp; const float* xs; const float* MOD;
    __device__ __forceinline__ void hook(pg8::f32x4 (&)[2][2][4][2], const pg8::Unit&, int, int, int, int, int) const {}
    __device__ __forceinline__ void operator()(const pg8::f32x4 (&acc)[2][2][4][2], const pg8::Unit& u, int wr, int wc, int fr, int fq) const {
        const int row0 = u.pm * 256 + wr * 64 + fr, col0 = u.pn * 256 + wc * 32 + 4 * fq;
#pragma unroll
        for (int ai = 0; ai < 2; ++ai)
#pragma unroll
            for (int m = 0; m < 4; ++m) { const int row = row0 + ai * 128 + m * 16;
                if (row < MTOT) {
                    const int bi = row < MP ? (row >> 11) : (8 + row - MP);
                    const float* x = row < MP ? xp + (size_t)row * D : xs + (size_t)(row - MP) * D;
                    const float* gt = MOD + (size_t)bi * 3072 + 2048;
#pragma unroll
                    for (int bj = 0; bj < 2; ++bj)
#pragma unroll
                        for (int n = 0; n < 2; ++n) { const int c = col0 + bj * 128 + n * 16;
                            const f32x4 xv = *(const f32x4*)(x + c), gv = *(const f32x4*)(gt + c);
                            *(f32x4*)(out + (size_t)row * D + c) = xv * ALPHA + gv * acc[ai][bj][m][n]; } } }
    }
};

__device__ __forceinline__ bf16x8 ldfrag(const LAS unsigned char* base, int stride, int row0, int k0, int fr, int fq) {
    return *(const LAS bf16x8*)(base + (row0 + fr) * stride + (k0 + 8 * fq) * 2);
}
__device__ __forceinline__ float bfx(const u32x4& v, int e) { return (e & 1) ? bfhi(v[e >> 1]) : bflo(v[e >> 1]); }
__device__ __forceinline__ float bfx2(const u32x2& v, int e) { return (e & 1) ? bfhi(v[e >> 1]) : bflo(v[e >> 1]); }

template <class T> __device__ __forceinline__ T ldg(const void* ubase, size_t uoff, unsigned voff) { return *(const T*)((const char*)ubase + uoff + (size_t)voff); }
template <class T> __device__ __forceinline__ void stg(void* ubase, size_t uoff, unsigned voff, T v) { *(T*)((char*)ubase + uoff + (size_t)voff) = v; }

__device__ __forceinline__ void ssd_prompt_item(const Args& a, LAS unsigned char* lds, int b, int h) {
    const int wid = __builtin_amdgcn_readfirstlane(threadIdx.x >> 6);
    const int g = h >> 3;
    constexpr int RS = 272, MATB = 128 * RS, HALFB = 64 * RS;
    constexpr int O_CC = 0, O_BC = MATB, O_BCT = 2 * MATB, O_XST = 3 * MATB, O_HB = 3 * MATB + HALFB, O_TAB = 3 * MATB + 2 * HALFB;
    LAS float* tab = (LAS float*)(lds + O_TAB) + wid * 256;
    const bf16_t* PROJ = (const bf16_t*)(a.ws + WS_PROJ); const float* DT = (const float*)(a.ws + WS_DT);
    bf16_t* YSSD = (bf16_t*)(a.ws + WS_YSSD); float* SSQ = (float*)(a.ws + WS_SSQ);
    const float A_h = -expf(a.in[I_ALOG][h]), D_h = a.in[I_SD][h], dtb = a.in[I_DTB][h];
    const float* cw = a.in[I_SCW]; const float* cb = a.in[I_SCB];
    const int l0 = 16 * wid;
    f32x4 sacc[4];
#pragma unroll
    for (int i = 0; i < 4; ++i) sacc[i] = (f32x4){0.f, 0.f, 0.f, 0.f};

    for (int c = 0; c < 16; ++c) {
        const size_t R0 = (size_t)b * TSEQ + 128 * c;
        float acs_last;
        {
            int t_ = threadIdx.x; LAUNDER(t_); const int lane = t_ & 63;
            const unsigned voD = (unsigned)(lane * 32 + h) * 4u;
            float dt0 = ldg<float>(DT, R0 * 128, voD), dt1 = ldg<float>(DT, (R0 + 64) * 128, voD);
            dt0 = softplus_acc(dt0 + dtb); dt1 = softplus_acc(dt1 + dtb);
            float s0 = dt0 * A_h, s1 = dt1 * A_h;
#pragma unroll
            for (int o = 1; o < 64; o <<= 1) { const float t0 = __shfl_up(s0, o), t1 = __shfl_up(s1, o); if (lane >= o) { s0 += t0; s1 += t1; } }
            s1 += __shfl(s0, 63);
            acs_last = __shfl(s1, 63);
            tab[lane] = s0; tab[64 + lane] = s1; tab[128 + lane] = dt0; tab[192 + lane] = dt1;
            LDS_WAIT(); CFENCE();
        }
        {
            int t_ = threadIdx.x; LAUNDER(t_);
            const int mat = t_ >> 8, tg = (t_ & 255) >> 4, oc = t_ & 15;
            const int chBC = 2048 + mat * 512 + g * 128 + 8 * oc;
            const unsigned voBC = (unsigned)((8 * tg) * NPAD + C_XBC + chBC) * 2u;
            u32x4 rawBC[11];
#pragma unroll
            for (int i = 0; i < 11; ++i) { const int tok = 8 * tg - 3 + i;
                if (c == 0 && tok < 0) rawBC[i] = (u32x4){0u, 0u, 0u, 0u};
                else rawBC[i] = ldg<u32x4>(PROJ, (R0 + i - 3) * (size_t)(NPAD * 2), voBC); }
            LAS unsigned char* rowp = lds + (mat ? O_CC : O_BC) + (8 * tg) * RS + 16 * oc;
            LAS unsigned char* colp = lds + O_BCT + (8 * oc) * RS + 16 * tg;
            LAS float* tabp = tab + 8 * tg;
#pragma unroll
            for (int hc = 0; hc < 2; ++hc) {
                f32x4 w[4], bv;
#pragma unroll
                for (int k = 0; k < 4; ++k) w[k] = ldg<f32x4>(cw, (size_t)(k * 3072 + 4 * hc) * 4, (unsigned)chBC * 4u);
                bv = ldg<f32x4>(cb, (size_t)(4 * hc) * 4, (unsigned)chBC * 4u);
                float oprev[4]; unsigned colpk[4][4];
#pragma unroll
                for (int j = 0; j < 8; ++j) {
                    float o[4];
#pragma unroll
                    for (int e = 0; e < 4; ++e) {
                        const int ee = 4 * hc + e;
                        float v = bv[e] + w[0][e] * bfx(rawBC[j], ee) + w[1][e] * bfx(rawBC[j + 1], ee) + w[2][e] * bfx(rawBC[j + 2], ee) + w[3][e] * bfx(rawBC[j + 3], ee);
                        o[e] = silu(v); }
                    u32x2 rp; rp.x = pk2(o[0], o[1]); rp.y = pk2(o[2], o[3]);
                    *(LAS u32x2*)(rowp + j * RS + 8 * hc) = rp;
                    if (mat == 0) {
                        const float de = fexp(acs_last - tabp[j]);
#pragma unroll
                        for (int e = 0; e < 4; ++e) { const float sv = o[e] * de; if (j & 1) colpk[e][j >> 1] = pk2(oprev[e], sv); else oprev[e] = sv; }
                    }
                }
                if (mat == 0) {
#pragma unroll
                    for (int e = 0; e < 4; ++e) { u32x4 cp; cp.x = colpk[e][0]; cp.y = colpk[e][1]; cp.z = colpk[e][2]; cp.w = colpk[e][3];
                        *(LAS u32x4*)(colp + (4 * hc + e) * RS) = cp; }
                }
                CFENCE();
            }
        }
        {
            int t_ = threadIdx.x; LAUNDER(t_);
            const int tg4 = t_ >> 4, qc = t_ & 15;
            const int chX = h * 64 + 4 * qc;
            const unsigned voX = (unsigned)((4 * tg4) * NPAD + C_XBC + chX) * 2u;
            u32x2 rawX[7];
#pragma unroll
            for (int i = 0; i < 7; ++i) { const int tok = 4 * tg4 - 3 + i;
                if (c == 0 && tok < 0) rawX[i] = (u32x2){0u, 0u};
                else rawX[i] = ldg<u32x2>(PROJ, (R0 + i - 3) * (size_t)(NPAD * 2), voX); }
            f32x4 w[4], bv;
#pragma unroll
            for (int k = 0; k < 4; ++k) w[k] = ldg<f32x4>(cw, (size_t)(k * 3072) * 4, (unsigned)chX * 4u);
            bv = ldg<f32x4>(cb, 0, (unsigned)chX * 4u);
            const f32x4 dt4 = *(const LAS f32x4*)(tab + 128 + 4 * tg4);
            float o[4][4];
#pragma unroll
            for (int j = 0; j < 4; ++j)
#pragma unroll
                for (int e = 0; e < 4; ++e) {
                    float v = bv[e] + w[0][e] * bfx2(rawX[j], e) + w[1][e] * bfx2(rawX[j + 1], e) + w[2][e] * bfx2(rawX[j + 2], e) + w[3][e] * bfx2(rawX[j + 3], e);
                    o[j][e] = silu(v) * dt4[j]; }
            LAS unsigned char* xp = lds + O_XST + (4 * qc) * RS + 8 * tg4;
#pragma unroll
            for (int e = 0; e < 4; ++e) { u32x2 cp; cp.x = pk2(o[0][e], o[1][e]); cp.y = pk2(o[2][e], o[3][e]);
                *(LAS u32x2*)(xp + e * RS) = cp; }
        }
        __syncthreads();
        f32x4 yacc[4], cbv[8];
        {
            int t_ = threadIdx.x; LAUNDER(t_); const int lane = t_ & 63, fr = lane & 15, fq = lane >> 4;
            const LAS unsigned char* fb = lds + fr * RS + 16 * fq;
            bf16x8 cf[4];
#pragma unroll
            for (int k = 0; k < 4; ++k) cf[k] = *(const LAS bf16x8*)(fb + O_CC + l0 * RS + 64 * k);
#pragma unroll
            for (int i = 0; i < 4; ++i) yacc[i] = (f32x4){0.f, 0.f, 0.f, 0.f};
            if (c > 0) {
#pragma unroll
                for (int pt = 0; pt < 4; ++pt)
#pragma unroll
                    for (int k = 0; k < 4; ++k) yacc[pt] = __builtin_amdgcn_mfma_f32_16x16x32_bf16(*(const LAS bf16x8*)(fb + O_HB + 16 * pt * RS + 64 * k), cf[k], yacc[pt], 0, 0, 0);
                const float ea = fexp(tab[l0 + fr]);
#pragma unroll
                for (int pt = 0; pt < 4; ++pt) yacc[pt] *= ea;
            }
#pragma unroll
            for (int st = 0; st < 8; ++st) { cbv[st] = (f32x4){0.f, 0.f, 0.f, 0.f};
#pragma unroll
                for (int k = 0; k < 4; ++k) cbv[st] = __builtin_amdgcn_mfma_f32_16x16x32_bf16(*(const LAS bf16x8*)(fb + O_BC + 16 * st * RS + 64 * k), cf[k], cbv[st], 0, 0, 0); }
            const float dec = fexp(acs_last);
#pragma unroll
            for (int pt = 0; pt < 4; ++pt) sacc[pt] *= dec;
#pragma unroll
            for (int k = 0; k < 4; ++k) { const bf16x8 bt = *(const LAS bf16x8*)(fb + O_BCT + l0 * RS + 64 * k);
#pragma unroll
                for (int pt = 0; pt < 4; ++pt) sacc[pt] = __builtin_amdgcn_mfma_f32_16x16x32_bf16(bt, *(const LAS bf16x8*)(fb + O_XST + 16 * pt * RS + 64 * k), sacc[pt], 0, 0, 0); }
        }
        __syncthreads();
        {
            int t_ = threadIdx.x; LAUNDER(t_); const int lane = t_ & 63, fr = lane & 15, fq = lane >> 4;
            const int l = l0 + fr; const float acs_l = tab[l], dl = D_h * frcp(tab[128 + l]);
            LAS unsigned char* mrow = lds + O_BC + l * RS + 8 * fq;
#pragma unroll
            for (int st = 0; st < 8; ++st) { const f32x4 as = *(const LAS f32x4*)(tab + 16 * st + 4 * fq);
                float m[4];
#pragma unroll
                for (int r = 0; r < 4; ++r) { const int sidx = 16 * st + 4 * fq + r; float v = cbv[st][r] * fexp(acs_l - as[r]); v = (sidx <= l) ? v : 0.f; m[r] = (sidx == l) ? v + dl : v; }
                u32x2 mp; mp.x = pk2(m[0], m[1]); mp.y = pk2(m[2], m[3]);
                *(LAS u32x2*)(mrow + 32 * st) = mp; }
            LDS_WAIT(); CFENCE();
            const LAS unsigned char* fb = lds + fr * RS + 16 * fq;
            const int kmax = wid >> 1;
            for (int k = 0; k <= kmax; ++k) { const bf16x8 mf = *(const LAS bf16x8*)(fb + O_BC + l0 * RS + 64 * k);
#pragma unroll
                for (int pt = 0; pt < 4; ++pt) yacc[pt] = __builtin_amdgcn_mfma_f32_16x16x32_bf16(*(const LAS bf16x8*)(fb + O_XST + 16 * pt * RS + 64 * k), mf, yacc[pt], 0, 0, 0); }
            const unsigned voZ = (unsigned)(fr * NPAD + C_SZ + h * 64 + 4 * fq) * 2u;
            const unsigned voY = (unsigned)(fr * 2048 + h * 64 + 4 * fq) * 2u, voS = (unsigned)(fr * 32 + h) * 4u;
            float ss = 0.f;
#pragma unroll
            for (int pt = 0; pt < 4; ++pt) {
                const u32x2 zr = ldg<u32x2>(PROJ, (R0 + l0) * (size_t)(NPAD * 2) + 32 * pt, voZ);
                const float g0 = yacc[pt][0] * silu(bflo(zr[0])), g1 = yacc[pt][1] * silu(bfhi(zr[0])), g2 = yacc[pt][2] * silu(bflo(zr[1])), g3 = yacc[pt][3] * silu(bfhi(zr[1]));
                ss += (g0 * g0 + g1 * g1) + (g2 * g2 + g3 * g3);
                u32x2 o; o.x = pk2(g0, g1); o.y = pk2(g2, g3);
                stg<u32x2>(YSSD, (R0 + l0) * (size_t)(2048 * 2) + 32 * pt, voY, o); }
            ss += __shfl_xor(ss, 16); ss += __shfl_xor(ss, 32);
            if (fq == 0) stg<float>(SSQ, (R0 + l0) * 128, voS, ss);
        }
        __syncthreads();
        if (c < 15) {
            int t_ = threadIdx.x; LAUNDER(t_); const int lane = t_ & 63, fr = lane & 15, fq = lane >> 4;
            LAS unsigned char* hp = lds + O_HB + fr * RS + (l0 + 4 * fq) * 2;
#pragma unroll
            for (int pt = 0; pt < 4; ++pt) { u32x2 o; o.x = pk2(sacc[pt][0], sacc[pt][1]); o.y = pk2(sacc[pt][2], sacc[pt][3]);
                *(LAS u32x2*)(hp + 16 * pt * RS) = o; }
        }
    }
    {
        const int lane = threadIdx.x & 63, fr = lane & 15, fq = lane >> 4;
        float* so = a.out + O_SHP + ((size_t)(b * NHEAD + h) * 64) * 128;
#pragma unroll
        for (int pt = 0; pt < 4; ++pt) *(f32x4*)(so + (size_t)(16 * pt + fr) * 128 + l0 + 4 * fq) = sacc[pt];
    }
    __syncthreads();
}

__device__ __forceinline__ void lru_prompt_item(const Args& a, LAS unsigned char* lds, int b, int nb, int half) {
    const int tid = threadIdx.x, lane = tid & 63, wid = __builtin_amdgcn_readfirstlane(tid >> 6), fr = lane & 15, fq = lane >> 4;
    constexpr int US = 144;
    LAS unsigned char* ub = lds;
    LAS unsigned char* gwl = lds + 18432;
    LAS unsigned char* uf = lds + 27648;
    LAS float* tot = (LAS float*)(lds + 46080);
    const bf16_t* PROJ = (const bf16_t*)(a.ws + WS_PROJ); bf16_t* YLRU = (bf16_t*)(a.ws + WS_YLRU);
    const bf16_t* GWT = (const bf16_t*)(a.ws + WS_GWT) + (size_t)nb * 8192;
    { const int r = tid >> 3, ck = tid & 7; const int srow = r < 32 ? half * 32 + r : 64 + half * 32 + (r - 32);
        *(LAS u32x4*)(gwl + r * US + 16 * ck) = *(const u32x4*)(GWT + (size_t)srow * 64 + 8 * ck); }
    const int tg = tid >> 4, qc = tid & 15;
    const int chq = nb * 64 + 4 * qc;
    f32x4 cwv[4], cbv;
#pragma unroll
    for (int k = 0; k < 4; ++k) cwv[k] = *(const f32x4*)(a.in[I_LCW] + k * 1024 + chq);
    cbv = *(const f32x4*)(a.in[I_LCB] + chq);
    float ba[2], bx[2], cl[2], carry[2];
#pragma unroll
    for (int ci = 0; ci < 2; ++ci) { const int ch = nb * 64 + half * 32 + 16 * ci + fr; ba[ci] = a.in[I_LBA][ch]; bx[ci] = a.in[I_LBX][ch]; cl[ci] = -8.0f * softplus_acc(-a.in[I_LAM][ch]); carry[ci] = 0.f; }
    const int t0w = 16 * wid;
    for (int c = 0; c < 16; ++c) {
        const size_t R0 = (size_t)b * TSEQ + 128 * c;
        u32x2 raw[7];
#pragma unroll
        for (int i = 0; i < 7; ++i) { const int tok = 4 * tg - 3 + i;
            if (c == 0 && tok < 0) raw[i] = (u32x2){0u, 0u};
            else raw[i] = *(const u32x2*)(PROJ + (R0 + tok) * NPAD + C_LX + chq); }
        bf16_t zr[2][4];
#pragma unroll
        for (int ci = 0; ci < 2; ++ci)
#pragma unroll
            for (int r = 0; r < 4; ++r) zr[ci][r] = PROJ[(R0 + t0w + 4 * fq + r) * NPAD + C_LZ + nb * 64 + half * 32 + 16 * ci + fr];
        {
            float o[4][4];
#pragma unroll
            for (int j = 0; j < 4; ++j)
#pragma unroll
                for (int e = 0; e < 4; ++e) o[j][e] = cbv[e] + cwv[0][e] * bfx2(raw[j], e) + cwv[1][e] * bfx2(raw[j + 1], e) + cwv[2][e] * bfx2(raw[j + 2], e) + cwv[3][e] * bfx2(raw[j + 3], e);
#pragma unroll
            for (int j = 0; j < 4; ++j) { u32x2 p; p.x = pk2(o[j][0], o[j][1]); p.y = pk2(o[j][2], o[j][3]);
                *(LAS u32x2*)(ub + (4 * tg + j) * US + 8 * qc) = p;
                if ((qc >> 3) == half) *(LAS f32x4*)(uf + (4 * tg + j) * US + 16 * (qc & 7)) = (f32x4){o[j][0], o[j][1], o[j][2], o[j][3]}; }
        }
        __syncthreads();
        f32x4 ga[4];
#pragma unroll
        for (int jt = 0; jt < 4; ++jt) { ga[jt] = (f32x4){0.f, 0.f, 0.f, 0.f};
#pragma unroll
            for (int k = 0; k < 2; ++k) ga[jt] = __builtin_amdgcn_mfma_f32_16x16x32_bf16(ldfrag(ub, US, t0w, 32 * k, fr, fq), ldfrag(gwl, US, 16 * jt, 32 * k, fr, fq), ga[jt], 0, 0, 0); }
        float Ar[2][4], Br[2][4];
#pragma unroll
        for (int ci = 0; ci < 2; ++ci) {
            float Aacc = 1.f, Bacc = 0.f;
#pragma unroll
            for (int r = 0; r < 4; ++r) {
                const float u = *(const LAS float*)(uf + (t0w + 4 * fq + r) * US + 4 * (16 * ci + fr));
                const float rg = sigm(ga[ci][r] + ba[ci]), ig = sigm(ga[2 + ci][r] + bx[ci]);
                const float la = cl[ci] * rg, av = fexp(la);
                float mult = sqrtf(neg_expm1(2.0f * la));
                if (c == 0 && wid == 0 && fq == 0 && r == 0) mult = 1.0f;
                const float bb = mult * ig * u;
                Bacc = av * Bacc + bb; Aacc = av * Aacc; Ar[ci][r] = Aacc; Br[ci][r] = Bacc; }
        }
        float Ap[2], Bp[2];
#pragma unroll
        for (int ci = 0; ci < 2; ++ci) { Ap[ci] = 1.f; Bp[ci] = 0.f;
#pragma unroll
            for (int k = 0; k < 3; ++k) { const float Ak = __shfl(Ar[ci][3], 16 * k + fr), Bk = __shfl(Br[ci][3], 16 * k + fr); if (k < fq) { Bp[ci] = Ak * Bp[ci] + Bk; Ap[ci] = Ak * Ap[ci]; } }
            if (fq == 3) { LAS float* tp = tot + (((c & 1) * 8 + wid) * 32 + 16 * ci + fr) * 2; tp[0] = Ar[ci][3] * Ap[ci]; tp[1] = Ar[ci][3] * Bp[ci] + Br[ci][3]; } }
        __syncthreads();
#pragma unroll
        for (int ci = 0; ci < 2; ++ci) {
            float hin = carry[ci], hw = 0.f;
#pragma unroll
            for (int w = 0; w < 8; ++w) { const LAS float* tp = tot + (((c & 1) * 8 + w) * 32 + 16 * ci + fr) * 2; if (w == wid) hw = hin; hin = tp[0] * hin + tp[1]; }
            carry[ci] = hin;
            const float hs = Ap[ci] * hw + Bp[ci];
            const int ch = half * 32 + 16 * ci + fr;
#pragma unroll
            for (int r = 0; r < 4; ++r) { const float hv = Ar[ci][r] * hs + Br[ci][r];
                const float y = hv * silu(bf1(zr[ci][r]));
                YLRU[(R0 + t0w + 4 * fq + r) * 1024 + nb * 64 + ch] = (bf16_t)(pk2(y, 0.f) & 0xffffu); }
        }
    }
    if (wid == 0 && fq == 0) {
#pragma unroll
        for (int ci = 0; ci < 2; ++ci) a.out[O_LHP + (size_t)b * 1024 + nb * 64 + half * 32 + 16 * ci + fr] = carry[ci];
    }
    __syncthreads();
}

__device__ __forceinline__ void ssd_sample_item(const Args& a, LAS unsigned char* lds, int b, int h) {
    const int tid = threadIdx.x, lane = tid & 63;
    const int g = h >> 3; const size_t row = (size_t)MP + b;
    LAS float* sv = (LAS float*)lds;
    LAS float* sg = sv + 384;
    const bf16_t* PROJ = (const bf16_t*)(a.ws + WS_PROJ); bf16_t* YSSD = (bf16_t*)(a.ws + WS_YSSD);
    if (tid < 320) {
        const int cch = tid < 64 ? h * 64 + tid : (tid < 192 ? 2048 + g * 128 + (tid - 64) : 2560 + g * 128 + (tid - 192));
        const float* buf = a.in[I_SSC] + (size_t)b * 3 * 3072 + cch; const float* cw = a.in[I_SCW] + cch;
        float v = a.in[I_SCB][cch] + cw[0] * buf[0] + cw[3072] * buf[3072] + cw[2 * 3072] * buf[2 * 3072] + cw[3 * 3072] * bf1(PROJ[row * NPAD + C_XBC + cch]);
        sv[tid] = silu(v);
    } else if (tid < 384) sv[tid] = bf1(PROJ[row * NPAD + C_SZ + h * 64 + (tid - 320)]);
    const float dts = softplus_acc(((const float*)(a.ws + WS_DT))[row * 32 + h] + a.in[I_DTB][h]);
    const float dA = expf(dts * -expf(a.in[I_ALOG][h])), D_h = a.in[I_SD][h];
    __syncthreads();
    const int l32 = tid & 31, prow = tid >> 5, n0 = 4 * l32;
    const float* hin = a.in[I_SSH] + ((size_t)(b * NHEAD + h) * 64) * 128; float* hout = a.out + O_SHS + ((size_t)(b * NHEAD + h) * 64) * 128;
    const f32x4 Bv = *(const LAS f32x4*)(sv + 64 + n0), Cv = *(const LAS f32x4*)(sv + 192 + n0);
    f32x4 h0[4];
#pragma unroll
    for (int ps = 0; ps < 4; ++ps) h0[ps] = *(const f32x4*)(hin + (size_t)(ps * 16 + prow) * 128 + n0);
#pragma unroll
    for (int ps = 0; ps < 4; ++ps) { const int pp = ps * 16 + prow; const float xv = sv[pp], xdt = dts * xv;
        const f32x4 hn = h0[ps] * dA + Bv * xdt;
        *(f32x4*)(hout + (size_t)pp * 128 + n0) = hn;
        float part = (hn[0] * Cv[0] + hn[1] * Cv[1]) + (hn[2] * Cv[2] + hn[3] * Cv[3]);
#pragma unroll
        for (int o = 1; o < 32; o <<= 1) part += __shfl_xor(part, o);
        if (l32 == 0) { const float y = part + D_h * xv; const float gv = y * silu(sv[320 + pp]);
            YSSD[row * 2048 + h * 64 + pp] = (bf16_t)(pk2(gv, 0.f) & 0xffffu); sg[pp] = gv * gv; } }
    __syncthreads();
    if (tid < 64) { const float s = wave_sum(sg[lane]); if (lane == 0) ((float*)(a.ws + WS_SSQ))[row * 32 + h] = s; }
    __syncthreads();
}

__device__ __forceinline__ void lru_sample_item(const Args& a, int b, int nb, int lane) {
    const int ch = nb * 64 + lane; const size_t row = (size_t)MP + b;
    const bf16_t* PROJ = (const bf16_t*)(a.ws + WS_PROJ); bf16_t* YLRU = (bf16_t*)(a.ws + WS_YLRU);
    const float* buf = a.in[I_SLC] + (size_t)b * 3 * 1024 + ch; const float* cw = a.in[I_LCW] + ch;
    const float px = bf1(PROJ[row * NPAD + C_LX + ch]);
    const float b0 = buf[0], b1 = buf[1024], b2 = buf[2048];
    const float u = a.in[I_LCB][ch] + cw[0] * b0 + cw[1024] * b1 + cw[2048] * b2 + cw[3072] * px;
    float gr = a.in[I_LBA][ch], gi = a.in[I_LBX][ch];
    const float* wa = a.in[I_LWA] + (size_t)nb * 4096 + lane; const float* wx = a.in[I_LWX] + (size_t)nb * 4096 + lane;
#pragma unroll 8
    for (int k = 0; k < 64; ++k) { const float uk = __shfl(u, k); gr += uk * wa[k * 64]; gi += uk * wx[k * 64]; }
    const float rg = sigm(gr), ig = sigm(gi);
    const float la = -8.0f * softplus_acc(-a.in[I_LAM][ch]) * rg, av = fexp(la), mult = sqrtf(neg_expm1(2.0f * la));
    const float hv = av * a.in[I_SLH][(size_t)b * 1024 + ch] + mult * ig * u;
    a.out[O_LHS + (size_t)b * 1024 + ch] = hv;
    const float y = hv * silu(bf1(PROJ[row * NPAD + C_LZ + ch]));
    YLRU[row * 1024 + ch] = (bf16_t)(pk2(y, 0.f) & 0xffffu);
    float* lc = a.out + O_LCS + (size_t)b * 3 * 1024 + ch; lc[0] = b1; lc[1024] = b2; lc[2048] = px;
}

#ifndef P3_SUB
#define P3_SUB 31
#endif
#ifndef REP_SUB
#define REP_SUB 31
#endif
__device__ __forceinline__ void p3_mixers(const Args& a, LAS unsigned char* lds, const int sub) {
    const int tid = threadIdx.x, lane = tid & 63, wid = __builtin_amdgcn_readfirstlane(tid >> 6);
    const int G = gridDim.x, bx = blockIdx.x;
    if (sub & 1) for (int it = bx; it < 256; it += G) { const int xcd = it & 7, slot = it >> 3, pair = xcd * 4 + (slot >> 3); ssd_prompt_item(a, lds, pair >> 2, (pair & 3) * 8 + (slot & 7)); }
    if (sub & 2) for (int it = bx; it < 256; it += G) lru_prompt_item(a, lds, it >> 5, (it >> 1) & 15, it & 1);
    if (sub & 4) for (int it = bx; it < NB_S * NHEAD; it += G) ssd_sample_item(a, lds, it >> 5, it & 31);
    const int gw = bx * 8 + wid, NGW = G * 8;
    if (sub & 8) for (int it = gw; it < NB_S * 16; it += NGW) lru_sample_item(a, it >> 4, it & 15, lane);
    if (!(sub & 16)) return;
    const bf16_t* PROJ = (const bf16_t*)(a.ws + WS_PROJ);
    const int gt = bx * 512 + tid, NGT = G * 512;
    for (int i = gt; i < NB_P * 3 * 1024; i += NGT) { const int bb = i / 3072, j = (i / 1024) % 3, c = i & 1023; a.out[O_LCP + i] = bf1(PROJ[((size_t)bb * TSEQ + 2045 + j) * NPAD + C_LX + c]); }
    for (int i = gt; i < NB_P * 3 * 3072; i += NGT) { const int bb = i / 9216, j = (i / 3072) % 3, c = i % 3072; a.out[O_SCP + i] = bf1(PROJ[((size_t)bb * TSEQ + 2045 + j) * NPAD + C_XBC + c]); }
    for (int i = gt; i < NB_S * 3 * 3072; i += NGT) { const int bb = i / 9216, j = (i / 3072) % 3, c = i % 3072;
        a.out[O_SCS + i] = j < 2 ? a.in[I_SSC][(size_t)bb * 9216 + (j + 1) * 3072 + c] : bf1(PROJ[((size_t)MP + bb) * NPAD + C_XBC + c]); }
}

__device__ __forceinline__ float ms8(const float* p) { const f32x4 a = *(const f32x4*)p, b = *(const f32x4*)(p + 4); return ((a[0] + a[1]) + (a[2] + a[3]) + (b[0] + b[1]) + (b[2] + b[3])) * (1.0f / 512.0f) + RMS_EPS; }
__device__ __forceinline__ void p4_sample(const Args& a, LAS unsigned char* lds) {
    const int tid = threadIdx.x, lane = tid & 63, wid = __builtin_amdgcn_readfirstlane(tid >> 6), fr = lane & 15, fq = lane >> 4;
    const int ct = wid & 1, kq = wid >> 1;
    LAS float* red = (LAS float*)lds;
    const bf16_t* YLRU = (const bf16_t*)(a.ws + WS_YLRU); const bf16_t* YSSD = (const bf16_t*)(a.ws + WS_YSSD);
    const bf16_t* WLRU = (const bf16_t*)(a.ws + WS_WLRU); const bf16_t* WSSD = (const bf16_t*)(a.ws + WS_WSSD);
    const bf16_t* PROJ = (const bf16_t*)(a.ws + WS_PROJ); const float* SSQ = (const float*)(a.ws + WS_SSQ); bf16_t* MG = (bf16_t*)(a.ws + WS_H);
    for (int task = blockIdx.x; task < 256; task += gridDim.x) {
        const int rt = task >> 5, cg = task & 31, row0 = MP + 16 * rt, col0 = 32 * cg + 16 * ct;
        f32x4 pa = (f32x4){0.f, 0.f, 0.f, 0.f}, pb = (f32x4){0.f, 0.f, 0.f, 0.f};
        const bf16_t* ap = YLRU + (size_t)(row0 + fr) * 1024 + 256 * kq + 8 * fq; const bf16_t* bp = WLRU + (size_t)(col0 + fr) * 1024 + 256 * kq + 8 * fq;
#pragma unroll
        for (int s = 0; s < 8; ++s) pa = __builtin_amdgcn_mfma_f32_16x16x32_bf16(*(const bf16x8*)(ap + 32 * s), *(const bf16x8*)(bp + 32 * s), pa, 0, 0, 0);
        const bf16_t* ap2 = YSSD + (size_t)(row0 + fr) * 2048 + 512 * kq + 8 * fq; const bf16_t* bp2 = WSSD + (size_t)(col0 + fr) * 2048 + 512 * kq + 8 * fq;
#pragma unroll
        for (int s = 0; s < 16; ++s) pb = __builtin_amdgcn_mfma_f32_16x16x32_bf16(*(const bf16x8*)(ap2 + 32 * s), *(const bf16x8*)(bp2 + 32 * s), pb, 0, 0, 0);
#pragma unroll
        for (int r = 0; r < 4; ++r) pb[r] *= __builtin_amdgcn_rsqf(ms8(SSQ + (size_t)(row0 + 4 * fq + r) * 32 + 8 * kq));
        *(LAS f32x4*)(red + ((wid * 2 + 0) * 64 + lane) * 4) = pa; *(LAS f32x4*)(red + ((wid * 2 + 1) * 64 + lane) * 4) = pb;
        __syncthreads();
        if (tid < 128) {
            f32x4 sa = (f32x4){0.f, 0.f, 0.f, 0.f}, sb = sa;
#pragma unroll
            for (int q = 0; q < 4; ++q) { const int w = q * 2 + wid; sa += *(const LAS f32x4*)(red + ((w * 2 + 0) * 64 + lane) * 4); sb += *(const LAS f32x4*)(red + ((w * 2 + 1) * 64 + lane) * 4); }
#pragma unroll
            for (int r = 0; r < 4; ++r) { const size_t row = row0 + 4 * fq + r; const int col = 32 * cg + 16 * wid + fr;
                const float gA = sigm(bf1(PROJ[row * NPAD + C_MG + col])), gB = sigm(bf1(PROJ[row * NPAD + C_MG + 1024 + col]));
                MG[row * 1024 + col] = (bf16_t)(pk2(gA * sa[r] + gB * sb[r], 0.f) & 0xffffu); }
        }
        __syncthreads();
    }
}
__device__ __forceinline__ void p5_sample(const Args& a, LAS unsigned char* lds) {
    const int tid = threadIdx.x, lane = tid & 63, wid = __builtin_amdgcn_readfirstlane(tid >> 6), fr = lane & 15, fq = lane >> 4;
    const int ct = wid & 1, kq = wid >> 1;
    LAS float* red = (LAS float*)lds;
    const bf16_t* MG = (const bf16_t*)(a.ws + WS_H); const bf16_t* WOUT = (const bf16_t*)(a.ws + WS_WOUT); const float* MOD = (const float*)(a.ws + WS_MOD);
    for (int task = blockIdx.x; task < 256; task += gridDim.x) {
        const int rt = task >> 5, cg = task & 31, row0 = MP + 16 * rt, col0 = 32 * cg + 16 * ct;
        f32x4 pa = (f32x4){0.f, 0.f, 0.f, 0.f};
        const bf16_t* ap = MG + (size_t)(row0 + fr) * 1024 + 256 * kq + 8 * fq; const bf16_t* bp = WOUT + (size_t)(col0 + fr) * 1024 + 256 * kq + 8 * fq;
#pragma unroll
        for (int s = 0; s < 8; ++s) pa = __builtin_amdgcn_mfma_f32_16x16x32_bf16(*(const bf16x8*)(ap + 32 * s), *(const bf16x8*)(bp + 32 * s), pa, 0, 0, 0);
        *(LAS f32x4*)(red + (wid * 64 + lane) * 4) = pa;
        __syncthreads();
        if (tid < 128) {
            f32x4 sa = (f32x4){0.f, 0.f, 0.f, 0.f};
#pragma unroll
            for (int q = 0; q < 4; ++q) sa += *(const LAS f32x4*)(red + (((q * 2 + wid)) * 64 + lane) * 4);
#pragma unroll
            for (int r = 0; r < 4; ++r) { const int rs = row0 - MP + 4 * fq + r; const int col = 32 * cg + 16 * wid + fr;
                a.out[(size_t)(MP + rs) * D + col] = ALPHA * a.in[I_XS][(size_t)rs * D + col] + MOD[(size_t)(8 + rs) * 3072 + 2048 + col] * sa[r]; }
        }
        __syncthreads();
    }
}

__device__ __forceinline__ void p6_layernorm(const Args& a) {
    const int tid = threadIdx.x, lane = tid & 63, wid = __builtin_amdgcn_readfirstlane(tid >> 6);
    const int gw = blockIdx.x * 8 + wid, NGW = gridDim.x * 8;
    const float* lg = a.in[I_LNG]; const float* lb = a.in[I_LNB];
    for (int row = gw; row < MTOT; row += NGW) {
        float* p = a.out + (size_t)row * D;
        f32x4 v[4]; float s = 0.f;
#pragma unroll
        for (int j = 0; j < 4; ++j) { v[j] = *(const f32x4*)(p + 4 * lane + 256 * j); s += (v[j][0] + v[j][1]) + (v[j][2] + v[j][3]); }
        const float mean = wave_sum(s) * (1.f / D); float s2 = 0.f;
#pragma unroll
        for (int j = 0; j < 4; ++j) { v[j] = v[j] - mean; s2 += (v[j][0] * v[j][0] + v[j][1] * v[j][1]) + (v[j][2] * v[j][2] + v[j][3] * v[j][3]); }
        const float rstd = __builtin_amdgcn_rsqf(wave_sum(s2) * (1.f / D) + LN_EPS);
#pragma unroll
        for (int j = 0; j < 4; ++j) { const int c = 4 * lane + 256 * j; const f32x4 gv = *(const f32x4*)(lg + c), bv = *(const f32x4*)(lb + c);
            *(f32x4*)(p + c) = v[j] * rstd * gv + bv; }
    }
}

__global__ void __launch_bounds__(512, 2) fwd(Args args) {
    extern __shared__ __attribute__((aligned(16))) unsigned char lds_raw[];
    LAS unsigned char* lds = (LAS unsigned char*)lds_raw;
    volatile LAS unsigned* MISC = (volatile LAS unsigned*)(lds + MISC_OFF);
    const int tid = threadIdx.x;
    if (tid < 64) MISC[tid] = 0u;
    __syncthreads();
    unsigned* ctl = (unsigned*)(args.ws + WS_CTL);
    XcdBarrier bar; bar.bar = ctl + 1024; bar.x = 0; bar.st = nullptr;
    if (N_LAUNCHES == 1) bar = xcd_barrier_post(ctl + 1024, MISC + 8);
    const int lo = args.ph_lo, hi = args.ph_hi;
#ifndef ONLY_PHASE
#define ONLY_PHASE -1
#endif
#define IN(k) ((ONLY_PHASE < 0 || ONLY_PHASE == (k)) && lo <= (k) && (k) < hi)
#define SEAM(k) do { if (IN(k) && IN((k) + 1)) xcd_barrier(bar); } while (0)
    const int G = gridDim.x;
#ifndef REP_PHASE
#define REP_PHASE -1
#endif
#define NREP(k) ((REP_PHASE == (k)) ? 2 : 1)
    if (IN(0)) { for (int rp = 0; rp < NREP(0); ++rp) { p0_prep(args, lds); __syncthreads(); } } SEAM(0);
    if (IN(1)) { for (int rp = 0; rp < NREP(1); ++rp) p1_modulate(args); } SEAM(1);
    if (IN(2)) for (int rp = 0; rp < NREP(2); ++rp) {
        pg8::Gemm g{(const pg8::bf16_t*)(args.ws + WS_H), (const pg8::bf16_t*)(args.ws + WS_WIN), MPAD, NPAD, 1024};
        pg8::StaticOrder S; S.init(MPAD, NPAD, G, (int)blockIdx.x);
        EpiProj E{(bf16_t*)(args.ws + WS_PROJ), (float*)(args.ws + WS_DT)};
        pg8::gemm_phase<EpiProj, pg8::StaticOrder, true, true>(lds, g, S, E);
    } SEAM(2);
    if (IN(3)) { p3_mixers(args, lds, P3_SUB);
#if REP_PHASE == 3
        __syncthreads(); p3_mixers(args, lds, REP_SUB);
#endif
    } SEAM(3);
    if (IN(4)) for (int rp = 0; rp < NREP(4); ++rp) {
        p4_sample(args, lds);
        pg8::StaticOrder S; S.init(MP, 1024, G, (int)blockIdx.x);
        { pg8::Gemm g{(const pg8::bf16_t*)(args.ws + WS_YLRU), (const pg8::bf16_t*)(args.ws + WS_WLRU), MP, 1024, 1024};
          EpiLruT E{(bf16_t*)(args.ws + WS_TBUF), (const bf16_t*)(args.ws + WS_PROJ)};
          pg8::gemm_phase<EpiLruT, pg8::StaticOrder, true, true>(lds, g, S, E); }
        VM_WAIT(); __syncthreads();
        { pg8::Gemm g{(const pg8::bf16_t*)(args.ws + WS_YSSD), (const pg8::bf16_t*)(args.ws + WS_WSSD), MP, 1024, 2048};
          EpiMerge E{(bf16_t*)(args.ws + WS_H), (const bf16_t*)(args.ws + WS_TBUF), (const bf16_t*)(args.ws + WS_PROJ), (const float*)(args.ws + WS_SSQ)};
          pg8::gemm_phase<EpiMerge, pg8::StaticOrder, true, true>(lds, g, S, E); }
    } SEAM(4);
    if (IN(5)) for (int rp = 0; rp < NREP(5); ++rp) {
        p5_sample(args, lds);
        pg8::Gemm g{(const pg8::bf16_t*)(args.ws + WS_H), (const pg8::bf16_t*)(args.ws + WS_WOUT), MP, 1024, 1024};
        pg8::StaticOrder S; S.init(MP, 1024, G, (int)blockIdx.x);
        EpiOut E{args.out, args.in[I_XP], args.in[I_XS], (const float*)(args.ws + WS_MOD)};
        pg8::gemm_phase<EpiOut, pg8::StaticOrder, true, true>(lds, g, S, E);
    } SEAM(5);
    if (IN(6)) { p6_layernorm(args); }
#undef IN
#undef SEAM
}

extern "C" void kernel_launch(void* const* d_in, const int* in_sizes, int n_in, void* d_out, int out_size, void* d_ws, size_t ws_size, hipStream_t stream) {
    static int grid = 0;
    if (grid == 0) {
        if (n_in != 29 || (size_t)out_size != O_END || ws_size < WS_END) { fprintf(stderr, "kernel_launch: unexpected shapes: n_in %d out %d ws %zu (need %zu)\n", n_in, out_size, ws_size, (size_t)WS_END); grid = -1; return; }
        int dev = 0, cus = 0, per_cu = 0;
        if (hipGetDevice(&dev) != hipSuccess || hipDeviceGetAttribute(&cus, hipDeviceAttributeMultiprocessorCount, dev) != hipSuccess) { grid = -1; return; }
        if (hipFuncSetAttribute((const void*)fwd, hipFuncAttributeMaxDynamicSharedMemorySize, LDS_BYTES) != hipSuccess) { fprintf(stderr, "kernel_launch: hipFuncSetAttribute failed\n"); grid = -1; return; }
        if (hipOccupancyMaxActiveBlocksPerMultiprocessor(&per_cu, (const void*)fwd, 512, LDS_BYTES) != hipSuccess || per_cu < 1) { fprintf(stderr, "kernel_launch: occupancy query says %d blocks per CU\n", per_cu); (void)hipGetLastError(); per_cu = 1; }
        grid = cus;
    }
    if (grid < 0) return;
    (void)hipMemsetAsync((char*)d_ws + WS_CTL, 0, CTL_ZERO_BYTES, stream);
    Args a{};
    for (int i = 0; i < 29; ++i) a.in[i] = (const float*)d_in[i];
    a.out = (float*)d_out; a.ws = (unsigned char*)d_ws;
    if (N_LAUNCHES == 1) {
        a.ph_lo = 0; a.ph_hi = N_PHASES;
        void* kargs[] = {&a};
        hipError_t e = hipLaunchCooperativeKernel((const void*)fwd, dim3(grid), dim3(512), kargs, LDS_BYTES, stream);
        if (e != hipSuccess) fprintf(stderr, "kernel_launch: cooperative launch failed: %s (grid %d)\n", hipGetErrorString(e), grid);
    } else {
        for (int ph = 0; ph < N_PHASES; ++ph) { a.ph_lo = ph; a.ph_hi = ph + 1; hipLaunchKernelGGL(fwd, dim3(grid), dim3(512), LDS_BYTES, stream, a); }
    }
}
```

```cpp
#include <hip/hip_runtime.h>
#include <cstdio>
#include <cstdint>
namespace pg8 {
#define PG8_LAS __attribute__((address_space(3)))
typedef unsigned short bf16_t;
typedef short bf16x8 __attribute__((ext_vector_type(8)));
typedef float f32x4 __attribute__((ext_vector_type(4)));
typedef unsigned u32x4 __attribute__((ext_vector_type(4)));
constexpr int BM = 256, BK = 64, HALF = 128, HTB = HALF * BK * 2  , STAGE_BYTES = 8 * HTB, NXCD = 8, WGM = 8;

__host__ __device__ __forceinline__ int lds_byte(int r, int c) { const int st = (r >> 4) * 2 + (c >> 5), rr = r & 15, cc = c & 31, ob = rr * 64 + cc * 2; return st * 1024 + (ob ^ (((ob >> 9) & 1) << 5)); }
__host__ __device__ __forceinline__ void stage_rc(int b, int& R, int& C) { const int st = b / 1024, sb = b % 1024, swz = sb ^ (((sb >> 9) & 1) << 5); R = (st >> 1) * 16 + swz / 64; C = (st & 1) * 32 + (swz % 64) / 2; }
__host__ __device__ __forceinline__ int perm32(int rho) { const int n = rho >> 4, i = rho & 15; return 8 * (i >> 2) + 4 * n + (i & 3); }

struct Unit { int pm, pn; };
struct Gemm { const bf16_t* A; const bf16_t* Bt; int M, N, K; };

struct StaticOrder {
    int nM, nN, nwg, G, c;
    __host__ __device__ void init(int M, int N, int G_, int c_) { nM = M / BM; nN = N / BM; nwg = nM * nN; G = G_; c = c_; }
    __host__ __device__ bool next(int i, Unit& u) const {
        const long L = (long)i * G + c; if (L >= nwg) return false;
        int wgid = (int)L; { const int q = nwg / NXCD, r = nwg % NXCD, xcd = wgid % NXCD, off = wgid / NXCD; wgid = (xcd < r ? xcd * (q + 1) : r * (q + 1) + (xcd - r) * q) + off; }
        const int nig = WGM * nN, gid = wgid / nig, fm = gid * WGM, gsz = (nM - fm) < WGM ? (nM - fm) : WGM;
        u.pm = fm + ((wgid % nig) % gsz); u.pn = (wgid % nig) / gsz; return true;
    }
    __device__ __forceinline__ void a_ready(const Unit&) const {}
    __device__ __forceinline__ void done(const Unit&) const {}
};
typedef float cvt_f32x2 __attribute__((ext_vector_type(2)));
typedef __bf16 cvt_bf16x2 __attribute__((ext_vector_type(2)));
__device__ __forceinline__ unsigned cvt_pk_bf16(float lo, float hi) { const cvt_f32x2 v = {lo, hi}; const cvt_bf16x2 r = __builtin_convertvector(v, cvt_bf16x2); return __builtin_bit_cast(unsigned, r); }
template <class Epi, class Sched, bool ALIGN_EPI = false, bool SP2 = false>
__device__ __forceinline__ void gemm_phase(PG8_LAS unsigned char* lds, const Gemm g, const Sched& S, const Epi& E) {
    const int tid = threadIdx.x, wid = __builtin_amdgcn_readfirstlane(tid >> 6), lane = tid & 63, wr = wid >> 2, wc = wid & 3, fr = lane & 15, fq = lane >> 4;
    const int K = g.K, nt = K / BK;
    unsigned voffA[2], voffB[2];
#pragma unroll
    for (int i = 0; i < 2; ++i) { int R, C; stage_rc(tid * 16 + i * 8192, R, C); const int Rb = Epi::PERM ? ((R & ~31) + perm32(R & 31)) : R;
        voffA[i] = (unsigned)(R * K + C) * 2u; voffB[i] = (unsigned)(Rb * K + C) * 2u; }
    const size_t kstep = (size_t)(BK * 2);
    const size_t hstep = (size_t)HALF * K * 2;
    const size_t tstep = 2 * hstep;
    const unsigned ldsw = (unsigned)wid * 1024u;
    const int aoff = lds_byte(wr * 64 + fr, fq * 8), boff = lds_byte(wc * 32 + fr, fq * 8);
#define PG8_SA(b, h) (((b) * 2 + (h)) * HTB)
#define PG8_SB(b, h) ((4 + (b) * 2 + (h)) * HTB)
#define PG8_STAGE(bufoff, gbase, voff) do { _Pragma("unroll") for (int _i = 0; _i < 2; ++_i) \
        __builtin_amdgcn_global_load_lds((const unsigned*)((const char*)(gbase) + (voff)[_i]), (PG8_LAS unsigned*)(lds + (bufoff) + ldsw + _i * 8192), 16, 0, 0); } while (0)
#define PG8_LDA(dst, b, h) do { _Pragma("unroll") for (int m = 0; m < 4; ++m) _Pragma("unroll") for (int k = 0; k < 2; ++k) dst[m][k] = *(const PG8_LAS bf16x8*)(lds + PG8_SA(b, h) + aoff + m * 2048 + k * 1024); } while (0)
#define PG8_LDB(dst, b, h) do { _Pragma("unroll") for (int n = 0; n < 2; ++n) _Pragma("unroll") for (int k = 0; k < 2; ++k) dst[n][k] = *(const PG8_LAS bf16x8*)(lds + PG8_SB(b, h) + boff + n * 2048 + k * 1024); } while (0)
#define PG8_MMA(ai, bj, At, Bt) do { __builtin_amdgcn_s_setprio(1); _Pragma("unroll") for (int m = 0; m < 4; ++m) _Pragma("unroll") for (int n = 0; n < 2; ++n) _Pragma("unroll") for (int k = 0; k < 2; ++k) \
        acc[ai][bj][m][n] = __builtin_amdgcn_mfma_f32_16x16x32_bf16(Bt[n][k], At[m][k], acc[ai][bj][m][n], 0, 0, 0); __builtin_amdgcn_s_setprio(0); } while (0)
#define PG8_WAIT_V(n) asm volatile("s_waitcnt vmcnt(" #n ")" ::: "memory")
#define PG8_WAIT_L(n) asm volatile("s_waitcnt lgkmcnt(" #n ")" ::: "memory")
#define PG8_BAR __builtin_amdgcn_s_barrier()
#define PG8_SCHED __builtin_amdgcn_sched_barrier(0)
    Unit cur, nxt; int ui = 0;
    if (!S.next(0, cur)) return;
    f32x4 acc[2][2][4][2];
#pragma unroll
    for (int a = 0; a < 2; ++a)
#pragma unroll
        for (int b = 0; b < 2; ++b)
#pragma unroll
            for (int m = 0; m < 4; ++m)
#pragma unroll
                for (int n = 0; n < 2; ++n) acc[a][b][m][n] = (f32x4){0.f, 0.f, 0.f, 0.f};
    bf16x8 At[4][2], B0[2][2], B1[2][2];
    const char* cA = (const char*)g.A + (size_t)cur.pm * tstep; const char* cB = (const char*)g.Bt + (size_t)cur.pn * tstep;
    S.a_ready(cur);
    if constexpr (SP2) {
        PG8_STAGE(PG8_SB(0, 0), cB, voffB); PG8_STAGE(PG8_SB(0, 1), cB + hstep, voffB); PG8_STAGE(PG8_SA(0, 0), cA, voffA); PG8_STAGE(PG8_SA(0, 1), cA + hstep, voffA);
        if (wr == 1) PG8_BAR;
        PG8_WAIT_V(2); PG8_BAR;
        PG8_STAGE(PG8_SB(1, 0), cB + kstep, voffB); PG8_STAGE(PG8_SA(1, 0), cA + kstep, voffA); PG8_STAGE(PG8_SB(1, 1), cB + hstep + kstep, voffB);
        PG8_WAIT_V(6); PG8_BAR;
    } else {
        PG8_STAGE(PG8_SB(0, 0), cB, voffB); PG8_STAGE(PG8_SA(0, 0), cA, voffA); PG8_STAGE(PG8_SB(0, 1), cB + hstep, voffB); PG8_STAGE(PG8_SA(0, 1), cA + hstep, voffA);
        if (wr == 1) PG8_BAR;
        PG8_WAIT_V(4); PG8_BAR;
        PG8_STAGE(PG8_SB(1, 0), cB + kstep, voffB); PG8_STAGE(PG8_SA(1, 0), cA + kstep, voffA); PG8_STAGE(PG8_SB(1, 1), cB + hstep + kstep, voffB);
        PG8_WAIT_V(6); PG8_BAR;
    }
    for (;;) {
        const bool has_next = S.next(ui + 1, nxt);
        const char* nA = has_next ? (const char*)g.A + (size_t)nxt.pm * tstep : cA; const char* nB = has_next ? (const char*)g.Bt + (size_t)nxt.pn * tstep : cB;
        for (int t = 0; t < nt; t += 2) {
            const bool last = (t == nt - 2);
            const char* a1 = cA + (size_t)(t + 1) * kstep;
            const char* a2 = last ? nA : cA + (size_t)(t + 2) * kstep; const char* b2 = last ? nB : cB + (size_t)(t + 2) * kstep;
            const char* a3 = a2 + kstep; const char* b3 = b2 + kstep;
            if (last && has_next) S.a_ready(nxt);
            if constexpr (Epi::HOOK) { if (t >= 8 && t <= 32 && (t & 7) == 0) E.hook(acc, cur, t, wr, wc, fr, fq); }
            if constexpr (SP2) {
            PG8_LDB(B0, 0, 0); PG8_LDB(B1, 0, 1); PG8_SCHED; PG8_LDA(At, 0, 0); PG8_STAGE(PG8_SA(1, 1), a1 + hstep, voffA);
            PG8_WAIT_V(8); PG8_WAIT_L(0); PG8_BAR; PG8_MMA(0, 0, At, B0); PG8_MMA(0, 1, At, B1); PG8_BAR; PG8_SCHED;
            PG8_LDA(At, 0, 1); PG8_STAGE(PG8_SB(0, 0), b2, voffB); PG8_STAGE(PG8_SB(0, 1), b2 + hstep, voffB); PG8_STAGE(PG8_SA(0, 0), a2, voffA);
            PG8_WAIT_V(8); PG8_WAIT_L(0); PG8_BAR; PG8_MMA(1, 0, At, B0); PG8_MMA(1, 1, At, B1); PG8_BAR; PG8_SCHED;
            PG8_LDB(B0, 1, 0); PG8_LDB(B1, 1, 1); PG8_SCHED; PG8_LDA(At, 1, 0); PG8_STAGE(PG8_SA(0, 1), a2 + hstep, voffA);
            PG8_WAIT_V(8); PG8_WAIT_L(0); PG8_BAR; PG8_MMA(0, 0, At, B0); PG8_MMA(0, 1, At, B1); PG8_BAR; PG8_SCHED;
            PG8_LDA(At, 1, 1); PG8_STAGE(PG8_SB(1, 0), b3, voffB); PG8_STAGE(PG8_SB(1, 1), b3 + hstep, voffB); PG8_STAGE(PG8_SA(1, 0), a3, voffA);
            PG8_WAIT_V(8); PG8_WAIT_L(0); PG8_BAR; PG8_MMA(1, 0, At, B0); PG8_MMA(1, 1, At, B1); PG8_BAR; PG8_SCHED;
            } else {
            PG8_LDB(B0, 0, 0); PG8_SCHED; PG8_LDA(At, 0, 0); PG8_STAGE(PG8_SA(1, 1), a1 + hstep, voffA);
            PG8_WAIT_L(8); PG8_BAR; PG8_WAIT_L(0); PG8_MMA(0, 0, At, B0); PG8_BAR; PG8_SCHED;
            PG8_LDB(B1, 0, 1); PG8_STAGE(PG8_SB(0, 0), b2, voffB);
            PG8_BAR; PG8_WAIT_L(0); PG8_MMA(0, 1, At, B1); PG8_BAR;
            PG8_LDA(At, 0, 1); PG8_STAGE(PG8_SA(0, 0), a2, voffA);
            PG8_BAR; PG8_WAIT_L(0); PG8_MMA(1, 0, At, B0); PG8_BAR; PG8_SCHED;
            PG8_STAGE(PG8_SB(0, 1), b2 + hstep, voffB);
            PG8_WAIT_V(6); PG8_BAR; PG8_MMA(1, 1, At, B1); PG8_BAR;
            PG8_LDB(B0, 1, 0); PG8_SCHED; PG8_LDA(At, 1, 0); PG8_STAGE(PG8_SA(0, 1), a2 + hstep, voffA);
            PG8_WAIT_L(8); PG8_BAR; PG8_WAIT_L(0); PG8_MMA(0, 0, At, B0); PG8_BAR; PG8_SCHED;
            PG8_LDB(B1, 1, 1); PG8_STAGE(PG8_SB(1, 0), b3, voffB);
            PG8_BAR; PG8_WAIT_L(0); PG8_MMA(0, 1, At, B1); PG8_BAR;
            PG8_LDA(At, 1, 1); PG8_STAGE(PG8_SA(1, 0), a3, voffA);
            PG8_BAR; PG8_WAIT_L(0); PG8_MMA(1, 0, At, B0); PG8_BAR; PG8_SCHED;
            PG8_STAGE(PG8_SB(1, 1), b3 + hstep, voffB);
            PG8_WAIT_V(6); PG8_BAR; PG8_MMA(1, 1, At, B1); PG8_BAR;
            }
        }
        if constexpr (ALIGN_EPI) { if (wr == 0) PG8_BAR; }
        if constexpr (!Epi::AFTER_DRAIN) { E(acc, cur, wr, wc, fr, fq); S.done(cur); }
        if (!has_next) break;
#pragma unroll
        for (int a = 0; a < 2; ++a)
#pragma unroll
            for (int b = 0; b < 2; ++b)
#pragma unroll
                for (int m = 0; m < 4; ++m)
#pragma unroll
                    for (int n = 0; n < 2; ++n) acc[a][b][m][n] = (f32x4){0.f, 0.f, 0.f, 0.f};
        cur = nxt; cA = nA; cB = nB; ++ui;
        if constexpr (ALIGN_EPI) { if (wr == 1) PG8_BAR; }
    }
    PG8_WAIT_V(0);
    if constexpr (!ALIGN_EPI) { if (wr == 0) PG8_BAR; }
    PG8_BAR;
    if constexpr (Epi::AFTER_DRAIN) { E.fused(acc, cur, wr, wc, fr, fq, lds, wid, lane); S.done(cur); }
#undef PG8_SA
#undef PG8_SB
#undef PG8_STAGE
#undef PG8_LDA
#undef PG8_LDB
#undef PG8_MMA
#undef PG8_WAIT_V
#undef PG8_WAIT_L
#undef PG8_BAR
#undef PG8_SCHED
}
}

#ifndef MK_N_LAUNCHES
#define MK_N_LAUNCHES 1
#endif
constexpr int N_LAUNCHES = MK_N_LAUNCHES;
constexpr int N_PHASES = 8;
constexpr int D = 1024, TSEQ = 2048, NB_P = 8, NB_S = 128;
constexpr int MP = NB_P * TSEQ;
constexpr int MTOT = MP + NB_S;
constexpr int MPAD = 16640;
constexpr int NPAD = 9472;
constexpr int C_LX = 0, C_LZ = 1024, C_SZ = 2048, C_XBC = 4096, C_MG = 7168, C_DT = 9216;
constexpr int NHEAD = 32;
constexpr float LN_EPS = 1e-5f, RMS_EPS = 1e-5f;
constexpr float ALPHA = 1.189207115002721f;
constexpr size_t O_Y = 0, O_LHP = 16908288, O_LCP = 16916480, O_SHP = 16941056, O_SCP = 19038208,
                 O_LHS = 19111936, O_LCS = 19243008, O_SHS = 19636224, O_SCS = 53190656, O_END = 54370304;
constexpr size_t MiB = 1u << 20;
constexpr size_t WS_CTL = 0, CTL_ZERO_BYTES = 64 * 1024;
constexpr size_t WS_MOD = 1 * MiB, WS_GWT = 3 * MiB, WS_DT = 4 * MiB, WS_SSQ = 7 * MiB, WS_WOUT = 10 * MiB, WS_WSSD = 12 * MiB, WS_WLRU = 16 * MiB,
                 WS_WIN = 18 * MiB, WS_H = 37 * MiB, WS_YSSD = 70 * MiB, WS_YLRU = 136 * MiB, WS_PROJ = 169 * MiB, WS_TBUF = 470 * MiB, WS_END = 503 * MiB;
static_assert(WS_WIN + (size_t)NPAD * 1024 * 2 <= WS_H && WS_H + (size_t)MPAD * 1024 * 2 <= WS_YSSD && WS_YSSD + (size_t)MPAD * 2048 * 2 <= WS_YLRU && WS_YLRU + (size_t)MPAD * 1024 * 2 <= WS_PROJ
              && WS_PROJ + (size_t)MPAD * NPAD * 2 <= WS_TBUF && WS_TBUF + (size_t)MPAD * 1024 * 2 <= WS_END, "ws map");
constexpr size_t WS_BCB = WS_H, WS_BCBT = WS_H + 16 * MiB, WS_BCC = WS_WIN;
static_assert(WS_BCBT + 16 * MiB <= WS_YSSD && WS_BCC + 16 * MiB <= WS_H, "BC tile aliases");
constexpr int LDS_BYTES = 155648;
constexpr int MISC_OFF = 155648 - 256;

#define LAS __attribute__((address_space(3)))
typedef unsigned short bf16_t;
typedef float f32x4 __attribute__((ext_vector_type(4)));
typedef float f32x2 __attribute__((ext_vector_type(2)));
typedef short bf16x8 __attribute__((ext_vector_type(8)));
typedef unsigned u32x4 __attribute__((ext_vector_type(4)));
typedef unsigned u32x2 __attribute__((ext_vector_type(2)));

__device__ __forceinline__ unsigned pk2(float lo, float hi) { return pg8::cvt_pk_bf16(lo, hi); }
__device__ __forceinline__ float bflo(unsigned w) { return __uint_as_float(w << 16); }
__device__ __forceinline__ float bfhi(unsigned w) { return __uint_as_float(w & 0xffff0000u); }
__device__ __forceinline__ float bf1(bf16_t v) { return __uint_as_float(((unsigned)v) << 16); }
__device__ __forceinline__ float fexp(float x) { return __builtin_amdgcn_exp2f(x * 1.4426950408889634f); }
__device__ __forceinline__ float frcp(float x) { return __builtin_amdgcn_rcpf(x); }
__device__ __forceinline__ float sigm(float x) { return frcp(1.f + fexp(-x)); }
__device__ __forceinline__ float silu(float x) { return x * sigm(x); }
__device__ __forceinline__ float softplus_acc(float x) { return fmaxf(x, 0.f) + log1pf(expf(-fabsf(x))); }
__device__ __forceinline__ float neg_expm1(float x) {
    const float p = -x * (1.f + x * (0.5f + x * (0.16666667f + x * (0.041666668f + x * (0.0083333338f + x * 0.0013888889f)))));
    const float q = 1.f - fexp(x);
    return x > -0.3f ? p : q;
}
__device__ __forceinline__ float wave_sum(float v) {
#pragma unroll
    for (int o = 1; o < 64; o <<= 1) v += __shfl_xor(v, o);
    return v;
}
#define LDS_WAIT() asm volatile("s_waitcnt lgkmcnt(0)" ::: "memory")
#define VM_WAIT() asm volatile("s_waitcnt vmcnt(0)" ::: "memory")
#define CFENCE() asm volatile("" ::: "memory")
#define LAUNDER(v) asm volatile("" : "+v"(v))

#define XB_TMO      128
#define XB_XCNT(j)  (256  + 64 * (j))
#define XB_XSUB(j)  (1280 + 64 * (j))
#define XB_XGEN(j)  (2304 + 64 * (j))
#define XB_TOP      3328
#define XB_TOPGEN   3392
#define XCD_BAR_WORDS 3456
#define XB_SPIN_CAP (1u << 18)
__device__ __forceinline__ unsigned xb_ld(unsigned* p)              { return __hip_atomic_load(p, __ATOMIC_RELAXED, __HIP_MEMORY_SCOPE_AGENT); }
__device__ __forceinline__ unsigned xb_add(unsigned* p, unsigned v) { return __hip_atomic_fetch_add(p, v, __ATOMIC_RELAXED, __HIP_MEMORY_SCOPE_AGENT); }
__device__ __forceinline__ unsigned xb_xcc_id() { return (unsigned)__builtin_amdgcn_s_getreg((3 << 11) | 20) & 0xFu; }
#define XB_SPIN(cond, bar) do { unsigned _sp = 0; while (cond) { __builtin_amdgcn_s_sleep(1); \
    if ((++_sp & 255u) == 0u) { if (xb_ld(&(bar)[XB_TMO])) break; if (_sp > XB_SPIN_CAP) { atomicAdd(&(bar)[XB_TMO], 1u); break; } } } } while (0)
struct XcdBarrier { unsigned* bar; unsigned x; volatile LAS unsigned* st; };
__device__ __forceinline__ XcdBarrier xcd_barrier_post(unsigned* bar, volatile LAS unsigned* st) {
    XcdBarrier b; b.bar = bar; b.x = xb_xcc_id(); b.st = st;
    if (threadIdx.x == 0) (void)xb_add(&bar[XB_XCNT(b.x)], 1u);
    return b;
}
__device__ __forceinline__ void xcd_barrier_complete(unsigned* bar, unsigned x, unsigned& nloc, unsigned& nx) {
    const unsigned G = gridDim.x * gridDim.y * gridDim.z;
    unsigned sum, cnt, mine, sp = 0u;
    for (;;) {
        sum = 0u; cnt = 0u; mine = 0u;
#pragma unroll
        for (unsigned j = 0; j < 16; ++j) { const unsigned c = xb_ld(&bar[XB_XCNT(j)]); sum += c; cnt += (c > 0u) ? 1u : 0u; mine = (j == x) ? c : mine; }
        if (sum == G) break;
        __builtin_amdgcn_s_sleep(1);
        if ((++sp & 255u) == 0u) { if (xb_ld(&bar[XB_TMO])) break; if (sp > XB_SPIN_CAP) { atomicAdd(&bar[XB_TMO], 1u); break; } }
    }
    nloc = mine > 0u ? mine : 1u; nx = cnt > 0u ? cnt : 1u;
}
__device__ __forceinline__ void xcd_barrier(const XcdBarrier& b) {
    asm volatile("s_waitcnt vmcnt(0)" ::: "memory");
    __syncthreads();
    if (threadIdx.x == 0) {
        unsigned* bar = b.bar;
        __builtin_amdgcn_s_waitcnt(0);
        unsigned nloc = b.st[0], nx = b.st[1];
        if (nloc == 0u) { xcd_barrier_complete(bar, b.x, nloc, nx); b.st[0] = nloc; b.st[1] = nx; }
        const unsigned old = xb_add(&bar[XB_XSUB(b.x)], 1u);
        const unsigned gen = old / nloc;
        if (old + 1u == (gen + 1u) * nloc) {
            __builtin_amdgcn_fence(__ATOMIC_RELEASE, "agent");
            asm volatile("s_waitcnt vmcnt(0)" ::: "memory");
            const unsigned og = xb_add(&bar[XB_TOP], 1u);
            const unsigned tg = og / nx;
            if (og + 1u == (tg + 1u) * nx) xb_add(&bar[XB_TOPGEN], 1u);
            else XB_SPIN(xb_ld(&bar[XB_TOPGEN]) == tg, bar);
            __builtin_amdgcn_fence(__ATOMIC_ACQUIRE, "agent");
            xb_add(&bar[XB_XGEN(b.x)], 1u);
            asm volatile("s_waitcnt vmcnt(0)" ::: "memory");
        } else {
            XB_SPIN(xb_ld(&bar[XB_XGEN(b.x)]) == gen, bar);
            __builtin_amdgcn_fence(__ATOMIC_ACQUIRE, "agent");
            asm volatile("s_waitcnt vmcnt(0)" ::: "memory");
        }
    }
    __syncthreads();
}

struct Args { const float* in[29]; float* out; unsigned char* ws; int ph_lo, ph_hi; };
enum { I_XP = 0, I_XS, I_SLH, I_SLC, I_SSH, I_SSC, I_CP, I_CS, I_WCOND, I_BCOND, I_WIN, I_LCW, I_LCB, I_LWA, I_LBA, I_LWX, I_LBX, I_LAM,
       I_SCW, I_SCB, I_DTB, I_ALOG, I_SD, I_NORMW, I_WLRU, I_WSSD, I_WOUT, I_LNG, I_LNB };

__device__ __forceinline__ void transpose_item(const float* W, int ldw, int k0, int n0, bf16_t* WT, int ldt, int drow0, int dcol0, const float* kscale, LAS float* scr, int lane) {
#pragma unroll 8
    for (int i = 0; i < 32; ++i) { const int kk = 2 * i + (lane >> 5); float v = W[(size_t)(k0 + kk) * ldw + n0 + (lane & 31)]; if (kscale) v *= kscale[k0 + kk]; scr[kk * 33 + (lane & 31)] = v; }
    LDS_WAIT();
    const int c = lane & 7;
#pragma unroll
    for (int j = 0; j < 4; ++j) { const int n = (lane >> 3) + 8 * j; const LAS float* s = scr + (8 * c) * 33 + n;
        u32x4 o; o.x = pk2(s[0 * 33], s[1 * 33]); o.y = pk2(s[2 * 33], s[3 * 33]); o.z = pk2(s[4 * 33], s[5 * 33]); o.w = pk2(s[6 * 33], s[7 * 33]);
        *(u32x4*)(WT + (size_t)(drow0 + n) * ldt + dcol0 + 8 * c) = o; }
    LDS_WAIT();
}

__device__ __forceinline__ void p0_mod(const Args& a, LAS unsigned char* lds, int blk) {
    const int tid = threadIdx.x, lane = tid & 63, wid = __builtin_amdgcn_readfirstlane(tid >> 6), fr = lane & 15, fq = lane >> 4;
    const float* wc = a.in[I_WCOND]; const int n0 = blk * 16;
    float* MOD = (float*)(a.ws + WS_MOD);
    f32x4 acc[9];
#pragma unroll
    for (int i = 0; i < 9; ++i) acc[i] = (f32x4){0.f, 0.f, 0.f, 0.f};
    for (int ks = 0; ks < 4; ++ks) {
        const int k0 = (wid * 4 + ks) * 32 + 8 * fq;
        float bv[8];
#pragma unroll
        for (int j = 0; j < 8; ++j) bv[j] = wc[(size_t)(k0 + j) * 3072 + n0 + fr];
        union { bf16x8 v; unsigned u[4]; } bfr;
#pragma unroll
        for (int j = 0; j < 4; ++j) bfr.u[j] = pk2(bv[2 * j], bv[2 * j + 1]);
#pragma unroll
        for (int rt = 0; rt < 9; ++rt) {
            int row = 16 * rt + fr; row = row > 135 ? 135 : row;
            const float* src = row < 8 ? a.in[I_CP] + (size_t)row * 1024 : a.in[I_CS] + (size_t)(row - 8) * 1024;
            const f32x4 lo = *(const f32x4*)(src + k0), hi = *(const f32x4*)(src + k0 + 4);
            union { bf16x8 v; unsigned u[4]; } afr;
            afr.u[0] = pk2(lo[0], lo[1]); afr.u[1] = pk2(lo[2], lo[3]); afr.u[2] = pk2(hi[0], hi[1]); afr.u[3] = pk2(hi[2], hi[3]);
            acc[rt] = __builtin_amdgcn_mfma_f32_16x16x32_bf16(afr.v, bfr.v, acc[rt], 0, 0, 0);
        }
    }
    LAS float* red = (LAS float*)lds;
#pragma unroll
    for (int rt = 0; rt < 9; ++rt) *(LAS f32x4*)(red + ((wid * 9 + rt) * 64 + lane) * 4) = acc[rt];
    __syncthreads();
    for (int idx = tid; idx < 9 * 256; idx += 512) {
        const int rt = idx >> 8, rem = idx & 255, ln = rem >> 2, r = rem & 3;
        float s = 0.f;
#pragma unroll
        for (int w = 0; w < 8; ++w) s += red[((w * 9 + rt) * 64 + ln) * 4 + r];
        const int row = 16 * rt + 4 * (ln >> 4) + r, n = n0 + (ln & 15);
        if (row < 136) MOD[(size_t)row * 3072 + n] = s + a.in[I_BCOND][n];
    }
    __syncthreads();
}

__device__ __forceinline__ void p0_prep(const Args& a, LAS unsigned char* lds) {
    const int tid = threadIdx.x, lane = tid & 63, wid = __builtin_amdgcn_readfirstlane(tid >> 6);
    const int G = gridDim.x;
    for (int blk = blockIdx.x; blk < 192; blk += G) p0_mod(a, lds, blk);
    LAS float* scr = (LAS float*)(lds + wid * 16384);
    bf16_t* WIN = (bf16_t*)(a.ws + WS_WIN); bf16_t* WSSD = (bf16_t*)(a.ws + WS_WSSD); bf16_t* WLRU = (bf16_t*)(a.ws + WS_WLRU); bf16_t* WOUT = (bf16_t*)(a.ws + WS_WOUT); bf16_t* GWT = (bf16_t*)(a.ws + WS_GWT);
    const int gw = blockIdx.x * 8 + wid, NGW = G * 8;
    constexpr int I_A = 16 * 289, I_B = 32 * 32, I_C = 16 * 32, I_D = 16 * 32, I_E = 64;
    for (int it = gw; it < I_A + I_B + I_C + I_D + I_E; it += NGW) {
        int r = it;
        if (r < I_A) { const int kb = r / 289, nb = r % 289, n0 = 32 * nb; const int drow = n0 < 7168 ? n0 : (n0 < 7200 ? C_DT : n0 - 32);
            transpose_item(a.in[I_WIN], 9248, 64 * kb, n0, WIN, 1024, drow, 64 * kb, nullptr, scr, lane); continue; } r -= I_A;
        if (r < I_B) { const int kb = r / 32, nb = r % 32; transpose_item(a.in[I_WSSD], 1024, 64 * kb, 32 * nb, WSSD, 2048, 32 * nb, 64 * kb, a.in[I_NORMW], scr, lane); continue; } r -= I_B;
        if (r < I_C) { const int kb = r / 32, nb = r % 32; transpose_item(a.in[I_WLRU], 1024, 64 * kb, 32 * nb, WLRU, 1024, 32 * nb, 64 * kb, nullptr, scr, lane); continue; } r -= I_C;
        if (r < I_D) { const int kb = r / 32, nb = r % 32; transpose_item(a.in[I_WOUT], 1024, 64 * kb, 32 * nb, WOUT, 1024, 32 * nb, 64 * kb, nullptr, scr, lane); continue; } r -= I_D;
        { const int gate = r >> 5, m = (r >> 1) & 15, nb = r & 1;
            transpose_item(a.in[gate ? I_LWX : I_LWA] + (size_t)m * 4096, 64, 0, 32 * nb, GWT + (size_t)m * 8192, 64, gate * 64 + 32 * nb, 0, nullptr, scr, lane); }
    }
}

__device__ __forceinline__ void p1_modulate(const Args& a) {
    const int tid = threadIdx.x, lane = tid & 63, wid = __builtin_amdgcn_readfirstlane(tid >> 6);
    const int gw = blockIdx.x * 8 + wid, NGW = gridDim.x * 8;
    const float* MOD = (const float*)(a.ws + WS_MOD); bf16_t* H = (bf16_t*)(a.ws + WS_H);
    for (int row = gw; row < MTOT; row += NGW) {
        const int bi = row < MP ? (row >> 11) : (8 + row - MP);
        const float* x = row < MP ? a.in[I_XP] + (size_t)row * D : a.in[I_XS] + (size_t)(row - MP) * D;
        const float* md = MOD + (size_t)bi * 3072;
#pragma unroll
        for (int j = 0; j < 4; ++j) { const int c = 4 * lane + 256 * j;
            const f32x4 xv = *(const f32x4*)(x + c), sh = *(const f32x4*)(md + c), sc = *(const f32x4*)(md + 1024 + c);
            const f32x4 v = xv * (sc + 1.0f) + sh;
            u32x2 o; o.x = pk2(v[0], v[1]); o.y = pk2(v[2], v[3]);
            *(u32x2*)(H + (size_t)row * D + c) = o; }
    }
}

struct EpiProj {
    static constexpr bool PERM = true, AFTER_DRAIN = false, HOOK = false;
    bf16_t* O; float* DT;
    __device__ __forceinline__ void hook(pg8::f32x4 (&)[2][2][4][2], const pg8::Unit&, int, int, int, int, int) const {}
    __device__ __forceinline__ void operator()(const pg8::f32x4 (&acc)[2][2][4][2], const pg8::Unit& u, int wr, int wc, int fr, int fq) const {
        const int row0 = u.pm * 256 + wr * 64 + fr, col0 = u.pn * 256 + wc * 32 + 8 * fq;
#pragma unroll
        for (int ai = 0; ai < 2; ++ai)
#pragma unroll
            for (int m = 0; m < 4; ++m) { const int row = row0 + ai * 128 + m * 16; bf16_t* rowp = O + (size_t)row * NPAD + col0;
#pragma unroll
                for (int bj = 0; bj < 2; ++bj) { const pg8::f32x4 v0 = acc[ai][bj][m][0], v1 = acc[ai][bj][m][1];
                    u32x4 w; w.x = pk2(v0[0], v0[1]); w.y = pk2(v0[2], v0[3]); w.z = pk2(v1[0], v1[1]); w.w = pk2(v1[2], v1[3]);
                    *(u32x4*)(rowp + bj * 128) = w; }
                if (u.pn == 36 && wc == 0) { float* dp = DT + (size_t)row * 32 + 8 * fq; *(f32x4*)dp = acc[ai][0][m][0]; *(f32x4*)(dp + 4) = acc[ai][0][m][1]; } }
    }
};

__device__ __forceinline__ void mul4_inplace(pg8::f32x4& v, float f) {
    float x0 = v[0], x1 = v[1], x2 = v[2], x3 = v[3];
    asm("v_mul_f32_e32 %0, %1, %0" : "+v"(x0) : "v"(f)); asm("v_mul_f32_e32 %0, %1, %0" : "+v"(x1) : "v"(f));
    asm("v_mul_f32_e32 %0, %1, %0" : "+v"(x2) : "v"(f)); asm("v_mul_f32_e32 %0, %1, %0" : "+v"(x3) : "v"(f));
    v[0] = x0; v[1] = x1; v[2] = x2; v[3] = x3;
}
struct EpiLruT {
    static constexpr bool PERM = true, AFTER_DRAIN = false, HOOK = false;
    bf16_t* T; const bf16_t* PROJ;
    __device__ __forceinline__ void hook(pg8::f32x4 (&)[2][2][4][2], const pg8::Unit&, int, int, int, int, int) const {}
    __device__ __forceinline__ void operator()(const pg8::f32x4 (&acc)[2][2][4][2], const pg8::Unit& u, int wr, int wc, int fr, int fq) const {
        const int row0 = u.pm * 256 + wr * 64 + fr, col0 = u.pn * 256 + wc * 32 + 8 * fq;
#pragma unroll
        for (int ai = 0; ai < 2; ++ai)
#pragma unroll
            for (int m = 0; m < 4; ++m) { const int row = row0 + ai * 128 + m * 16;
#pragma unroll
                for (int bj = 0; bj < 2; ++bj) { const u32x4 la = *(const u32x4*)(PROJ + (size_t)row * NPAD + C_MG + col0 + bj * 128);
                    const pg8::f32x4 v0 = acc[ai][bj][m][0], v1 = acc[ai][bj][m][1];
                    u32x4 w; w.x = pk2(v0[0] * sigm(bflo(la[0])), v0[1] * sigm(bfhi(la[0]))); w.y = pk2(v0[2] * sigm(bflo(la[1])), v0[3] * sigm(bfhi(la[1])));
                    w.z = pk2(v1[0] * sigm(bflo(la[2])), v1[1] * sigm(bfhi(la[2]))); w.w = pk2(v1[2] * sigm(bflo(la[3])), v1[3] * sigm(bfhi(la[3])));
                    *(u32x4*)(T + (size_t)row * D + col0 + bj * 128) = w; CFENCE(); } }
    }
};
struct EpiMerge {
#ifndef HOOK_ON
#define HOOK_ON true
#endif
    static constexpr bool PERM = true, AFTER_DRAIN = false, HOOK = HOOK_ON;
    bf16_t* O; const bf16_t* T; const bf16_t* PROJ; const float* SSQ;
    __device__ __forceinline__ float ms(const float* p) const { const f32x4 a = *(const f32x4*)p, b = *(const f32x4*)(p + 4); return ((a[0] + a[1]) + (a[2] + a[3]) + (b[0] + b[1]) + (b[2] + b[3])) * (1.0f / 512.0f) + RMS_EPS; }
    __device__ __forceinline__ void hook(pg8::f32x4 (&acc)[2][2][4][2], const pg8::Unit& u, int t, int wr, int wc, int fr, int fq) const {
        if (t > 24) return;
        LAUNDER(fr);
        const int row0 = u.pm * 256 + wr * 64 + fr;
        const int g = (t >> 3) - 1;
#pragma unroll
        for (int ai = 0; ai < 2; ++ai)
#pragma unroll
            for (int m = 0; m < 4; ++m) { const int row = row0 + ai * 128 + m * 16; const float* sp = SSQ + (size_t)row * 32 + 8 * g;
                const float f = sqrtf(ms(sp + 8) * frcp(ms(sp)));
#pragma unroll
                for (int bj = 0; bj < 2; ++bj)
#pragma unroll
                    for (int n = 0; n < 2; ++n) mul4_inplace(acc[ai][bj][m][n], f);
                CFENCE(); }
    }
    __device__ __forceinline__ void operator()(const pg8::f32x4 (&acc)[2][2][4][2], const pg8::Unit& u, int wr, int wc, int fr, int fq) const {
        const int row0 = u.pm * 256 + wr * 64 + fr, col0 = u.pn * 256 + wc * 32 + 8 * fq;
#pragma unroll
        for (int ai = 0; ai < 2; ++ai)
#pragma unroll
            for (int m = 0; m < 4; ++m) { const int row = row0 + ai * 128 + m * 16; const float rs3 = __builtin_amdgcn_rsqf(ms(SSQ + (size_t)row * 32 + 24));
#pragma unroll
                for (int bj = 0; bj < 2; ++bj) { const u32x4 lb = *(const u32x4*)(PROJ + (size_t)row * NPAD + C_MG + 1024 + col0 + bj * 128);
                    const u32x4 tv = *(const u32x4*)(T + (size_t)row * D + col0 + bj * 128);
                    const pg8::f32x4 v0 = acc[ai][bj][m][0] * rs3, v1 = acc[ai][bj][m][1] * rs3;
                    u32x4 w; w.x = pk2(bflo(tv[0]) + v0[0] * sigm(bflo(lb[0])), bfhi(tv[0]) + v0[1] * sigm(bfhi(lb[0]))); w.y = pk2(bflo(tv[1]) + v0[2] * sigm(bflo(lb[1])), bfhi(tv[1]) + v0[3] * sigm(bfhi(lb[1])));
                    w.z = pk2(bflo(tv[2]) + v1[0] * sigm(bflo(lb[2])), bfhi(tv[2]) + v1[1] * sigm(bfhi(lb[2]))); w.w = pk2(bflo(tv[3]) + v1[2] * sigm(bflo(lb[3])), bfhi(tv[3]) + v1[3] * sigm(bfhi(lb[3])));
                    *(u32x4*)(O + (size_t)row * D + col0 + bj * 128) = w; CFENCE(); } }
    }
};

struct EpiOut {
    static constexpr bool PERM = false, AFTER_DRAIN = false, HOOK = false;
    float* out; const float* xp; const float* xs; const float* MOD;
    __device__ __forceinline__ void hook(pg8::f32x4 (&)[2][2][4][2], const pg8::Unit&, int, int, int, int, int) const {}
    __device__ __forceinline__ void operator()(const pg8::f32x4 (&acc)[2][2][4][2], const pg8::Unit& u, int wr, int wc, int fr, int fq) const {
        const int row0 = u.pm * 256 + wr * 64 + fr, col0 = u.pn * 256 + wc * 32 + 4 * fq;
#pragma unroll
        for (int ai = 0; ai < 2; ++ai)
#pragma unroll
            for (int m = 0; m < 4; ++m) { const int row = row0 + ai * 128 + m * 16;
                if (row < MTOT) {
                    const int bi = row < MP ? (row >> 11) : (8 + row - MP);
                    const float* x = row < MP ? xp + (size_t)row * D : xs + (size_t)(row - MP) * D;
                    const float* gt = MOD + (size_t)bi * 3072 + 2048;
#pragma unroll
                    for (int bj = 0; bj < 2; ++bj)
#pragma unroll
                        for (int n = 0; n < 2; ++n) { const int c = col0 + bj * 128 + n * 16;
                            const f32x4 xv = *(const f32x4*)(x + c), gv = *(const f32x4*)(gt + c);
                            *(f32x4*)(out + (size_t)row * D + c) = xv * ALPHA + gv * acc[ai][bj][m][n]; } } }
    }
};

__device__ __forceinline__ bf16x8 ldfrag(const LAS unsigned char* base, int stride, int row0, int k0, int fr, int fq) {
    return *(const LAS bf16x8*)(base + (row0 + fr) * stride + (k0 + 8 * fq) * 2);
}
__device__ __forceinline__ float bfx(const u32x4& v, int e) { return (e & 1) ? bfhi(v[e >> 1]) : bflo(v[e >> 1]); }
__device__ __forceinline__ float bfx2(const u32x2& v, int e) { return (e & 1) ? bfhi(v[e >> 1]) : bflo(v[e >> 1]); }

template <class T> __device__ __forceinline__ T ldg(const void* ubase, size_t uoff, unsigned voff) { return *(const T*)((const char*)ubase + uoff + (size_t)voff); }
template <class T> __device__ __forceinline__ void stg(void* ubase, size_t uoff, unsigned voff, T v) { *(T*)((char*)ubase + uoff + (size_t)voff) = v; }

__device__ __forceinline__ void ssd_bc_prepass(const Args& a, LAS unsigned char* lds) {
    constexpr int RS = 272, MATB = 128 * RS;
    const int wid = __builtin_amdgcn_readfirstlane(threadIdx.x >> 6);
    const bf16_t* PROJ = (const bf16_t*)(a.ws + WS_PROJ);
    bf16_t* CBG = (bf16_t*)(a.ws + WS_BCB); bf16_t* BCBT = (bf16_t*)(a.ws + WS_BCBT); bf16_t* BCC = (bf16_t*)(a.ws + WS_BCC);
    const float* cw = a.in[I_SCW]; const float* cb = a.in[I_SCB];
    for (int tile = blockIdx.x; tile < 512; tile += gridDim.x) {
#ifdef DBG_SYNC
        __syncthreads();
#endif
        {
            int t_ = threadIdx.x; LAUNDER(t_);
            const int g = tile & 3, c = (tile >> 2) & 15, b = tile >> 6;
            const int mat = t_ >> 8, tg = (t_ & 255) >> 4, oc = t_ & 15;
            const int chBC = 2048 + mat * 512 + g * 128 + 8 * oc;
            const size_t R0 = (size_t)b * TSEQ + 128 * c;
            const unsigned voBC = (unsigned)((8 * tg) * NPAD + C_XBC + chBC) * 2u;
            u32x4 raw[11];
#pragma unroll
            for (int i = 0; i < 11; ++i) { const int tok = 8 * tg - 3 + i;
                if (c == 0 && tok < 0) raw[i] = (u32x4){0u, 0u, 0u, 0u};
                else raw[i] = ldg<u32x4>(PROJ, (R0 + i - 3) * (size_t)(NPAD * 2), voBC); }
            bf16_t* rowp = BCC + (size_t)tile * 16384 + (8 * tg) * 128 + 8 * oc;
            bf16_t* colp = BCBT + (size_t)tile * 16384 + (8 * oc) * 128 + 8 * tg;
            LAS unsigned char* lrow = lds + (mat ? MATB : 0) + (8 * tg) * RS + 16 * oc;
#pragma unroll
            for (int hc = 0; hc < 2; ++hc) {
                f32x4 w[4], bv;
#pragma unroll
                for (int k = 0; k < 4; ++k) w[k] = ldg<f32x4>(cw, (size_t)(k * 3072 + 4 * hc) * 4, (unsigned)chBC * 4u);
                bv = ldg<f32x4>(cb, (size_t)(4 * hc) * 4, (unsigned)chBC * 4u);
                float oprev[4]; unsigned colpk[4][4];
#pragma unroll
                for (int j = 0; j < 8; ++j) {
                    float o[4];
#pragma unroll
                    for (int e = 0; e < 4; ++e) { const int ee = 4 * hc + e;
                        o[e] = silu(bv[e] + w[0][e] * bfx(raw[j], ee) + w[1][e] * bfx(raw[j + 1], ee) + w[2][e] * bfx(raw[j + 2], ee) + w[3][e] * bfx(raw[j + 3], ee)); }
                    u32x2 rp; rp.x = pk2(o[0], o[1]); rp.y = pk2(o[2], o[3]);
                    *(LAS u32x2*)(lrow + j * RS + 8 * hc) = rp;
                    if (mat == 1) *(u32x2*)(rowp + j * 128 + 4 * hc) = rp;
                    else {
#pragma unroll
                        for (int e = 0; e < 4; ++e) { if (j & 1) colpk[e][j >> 1] = pk2(oprev[e], o[e]); else oprev[e] = o[e]; }
                    }
                }
                if (mat == 0) {
#pragma unroll
                    for (int e = 0; e < 4; ++e) { u32x4 cp; cp.x = colpk[e][0]; cp.y = colpk[e][1]; cp.z = colpk[e][2]; cp.w = colpk[e][3];
                        *(u32x4*)(colp + (4 * hc + e) * 128) = cp; }
                }
                CFENCE();
            }
        }
        __syncthreads();
        {
            int t_ = threadIdx.x; LAUNDER(t_); const int lane = t_ & 63, fr = lane & 15, fq = lane >> 4;
            const int l0 = 16 * wid;
            const LAS unsigned char* fb = lds + fr * RS + 16 * fq;
            bf16x8 cf[4];
#pragma unroll
            for (int k = 0; k < 4; ++k) cf[k] = *(const LAS bf16x8*)(fb + MATB + l0 * RS + 64 * k);
            bf16_t* op = CBG + (size_t)tile * 16384 + (l0 + fr) * 128 + 4 * fq;
#pragma unroll
            for (int st = 0; st < 8; ++st) { f32x4 acc = (f32x4){0.f, 0.f, 0.f, 0.f};
#pragma unroll
                for (int k = 0; k < 4; ++k) acc = __builtin_amdgcn_mfma_f32_16x16x32_bf16(*(const LAS bf16x8*)(fb + 16 * st * RS + 64 * k), cf[k], acc, 0, 0, 0);
                u32x2 o; o.x = pk2(acc[0], acc[1]); o.y = pk2(acc[2], acc[3]);
                *(u32x2*)(op + 16 * st) = o; }
        }
        __syncthreads();
    }
}

struct SsdPre { u32x4 t[12]; u32x2 x[7]; float dt0, dt1; };
__device__ __forceinline__ void ssd_prefetch(SsdPre& P, const Args& a, int b, int h, int c, int l0) {
    int t_ = threadIdx.x; LAUNDER(t_);
    const int lane = t_ & 63, g = h >> 3;
    const size_t R0 = (size_t)b * TSEQ + 128 * c;
    const size_t tile = (size_t)((b * 16 + c) * 4 + g) * 32768;
    const unsigned vo = (unsigned)t_ * 16u;
#pragma unroll
    for (int i = 0; i < 4; ++i) { P.t[i] = ldg<u32x4>(a.ws + WS_BCC, tile + 8192 * i, vo); P.t[4 + i] = ldg<u32x4>(a.ws + WS_BCB, tile + 8192 * i, vo); P.t[8 + i] = ldg<u32x4>(a.ws + WS_BCBT, tile + 8192 * i, vo); }
    const int tg4 = t_ >> 4, qc = t_ & 15;
    const unsigned voX = (unsigned)((4 * tg4) * NPAD + C_XBC + h * 64 + 4 * qc) * 2u;
#pragma unroll
    for (int i = 0; i < 7; ++i) { const int tok = 4 * tg4 - 3 + i;
        if (c == 0 && tok < 0) P.x[i] = (u32x2){0u, 0u};
        else P.x[i] = ldg<u32x2>(a.ws + WS_PROJ, (R0 + i - 3) * (size_t)(NPAD * 2), voX); }
    const unsigned voD = (unsigned)(lane * 32 + h) * 4u;
    P.dt0 = ldg<float>(a.ws + WS_DT, R0 * 128, voD); P.dt1 = ldg<float>(a.ws + WS_DT, (R0 + 64) * 128, voD);
}
__device__ __forceinline__ void ssd_prompt_item(const Args& a, LAS unsigned char* lds, int b, int h) {
    const int wid = __builtin_amdgcn_readfirstlane(threadIdx.x >> 6);
    constexpr int RS = 272, MATB = 128 * RS, HALFB = 64 * RS;
    constexpr int O_CC = 0, O_M = MATB, O_BCT = 2 * MATB, O_XST = 3 * MATB, O_HB = 3 * MATB + HALFB, O_TAB = 3 * MATB + 2 * HALFB, O_CW = O_TAB + 8 * 384 * 4;
    LAS float* tab = (LAS float*)(lds + O_TAB) + wid * 384;
    LAS float* cwl = (LAS float*)(lds + O_CW);
    bf16_t* YSSD = (bf16_t*)(a.ws + WS_YSSD); float* SSQ = (float*)(a.ws + WS_SSQ);
    const float A_h = -expf(a.in[I_ALOG][h]), D_h = a.in[I_SD][h], dtb = a.in[I_DTB][h];
    const int l0 = 16 * wid;
    if (threadIdx.x < 320) { const int k = threadIdx.x >> 6, ch = threadIdx.x & 63; cwl[threadIdx.x] = k < 4 ? a.in[I_SCW][k * 3072 + h * 64 + ch] : a.in[I_SCB][h * 64 + ch]; }
    f32x4 sacc[4];
#pragma unroll
    for (int i = 0; i < 4; ++i) sacc[i] = (f32x4){0.f, 0.f, 0.f, 0.f};
    SsdPre P;
    ssd_prefetch(P, a, b, h, 0, l0);
    __syncthreads();

    for (int c = 0; c < 16; ++c) {
        const size_t R0 = (size_t)b * TSEQ + 128 * c;
        float acs_last2;
        {
            int t_ = threadIdx.x; LAUNDER(t_); const int lane = t_ & 63;
            const float dt0 = softplus_acc(P.dt0 + dtb), dt1 = softplus_acc(P.dt1 + dtb);
            float s0 = dt0 * (A_h * 1.4426950408889634f), s1 = dt1 * (A_h * 1.4426950408889634f);
#pragma unroll
            for (int o = 1; o < 64; o <<= 1) { const float t0 = __shfl_up(s0, o), t1 = __shfl_up(s1, o); if (lane >= o) { s0 += t0; s1 += t1; } }
            s1 += __shfl(s0, 63);
            acs_last2 = __shfl(s1, 63);
            tab[lane] = s0; tab[64 + lane] = s1; tab[128 + lane] = dt0; tab[192 + lane] = dt1;
            tab[256 + lane] = __builtin_amdgcn_exp2f(acs_last2 - s0); tab[320 + lane] = __builtin_amdgcn_exp2f(acs_last2 - s1);
        }
        LDS_WAIT(); CFENCE();
#ifdef DBG_SYNC
        __syncthreads();
#endif
        {
            int t_ = threadIdx.x; LAUNDER(t_);
            const int r0 = t_ >> 4, q = t_ & 15;
            LAS unsigned char* dp = lds + r0 * RS + q * 16;
#pragma unroll
            for (int i = 0; i < 4; ++i) { *(LAS u32x4*)(dp + O_CC + 32 * i * RS) = P.t[i]; *(LAS u32x4*)(dp + O_BCT + 32 * i * RS) = P.t[8 + i]; }
            const f32x4 as0 = *(const LAS f32x4*)(tab + 8 * q), as1 = *(const LAS f32x4*)(tab + 8 * q + 4);
#pragma unroll
            for (int i = 0; i < 4; ++i) {
                const int l = r0 + 32 * i, d = l - 8 * q;
                const float al = tab[l], dl = D_h * frcp(tab[128 + l]);
                const u32x4 cbr = P.t[4 + i];
                float m[8];
#pragma unroll
                for (int e = 0; e < 8; ++e) { const float cbe = (e & 1) ? bfhi(cbr[e >> 1]) : bflo(cbr[e >> 1]); const float ase = e < 4 ? as0[e] : as1[e - 4];
                    float v = cbe * __builtin_amdgcn_exp2f(al - ase); v = (e <= d) ? v : 0.f; m[e] = (e == d) ? v + dl : v; }
                u32x4 mp; mp.x = pk2(m[0], m[1]); mp.y = pk2(m[2], m[3]); mp.z = pk2(m[4], m[5]); mp.w = pk2(m[6], m[7]);
                *(LAS u32x4*)(dp + O_M + 32 * i * RS) = mp; }
        }
#ifdef DBG_SYNC
        __syncthreads();
#endif
        {
            int t_ = threadIdx.x; LAUNDER(t_);
            const int tg4 = t_ >> 4, qc = t_ & 15;
            f32x4 w[4], bv;
#pragma unroll
            for (int k = 0; k < 4; ++k) w[k] = *(const LAS f32x4*)(cwl + 64 * k + 4 * qc);
            bv = *(const LAS f32x4*)(cwl + 256 + 4 * qc);
            const f32x4 dt4 = *(const LAS f32x4*)(tab + 128 + 4 * tg4);
            float o[4][4];
#pragma unroll
            for (int j = 0; j < 4; ++j)
#pragma unroll
                for (int e = 0; e < 4; ++e) {
                    float v = bv[e] + w[0][e] * bfx2(P.x[j], e) + w[1][e] * bfx2(P.x[j + 1], e) + w[2][e] * bfx2(P.x[j + 2], e) + w[3][e] * bfx2(P.x[j + 3], e);
                    o[j][e] = silu(v) * dt4[j]; }
            LAS unsigned char* xp = lds + O_XST + (4 * qc) * RS + 8 * tg4;
#pragma unroll
            for (int e = 0; e < 4; ++e) { u32x2 cp; cp.x = pk2(o[0][e], o[1][e]); cp.y = pk2(o[2][e], o[3][e]);
                *(LAS u32x2*)(xp + e * RS) = cp; }
        }
        __syncthreads();
        if (c < 15) ssd_prefetch(P, a, b, h, c + 1, l0);
        {
            int t_ = threadIdx.x; LAUNDER(t_); const int lane = t_ & 63, fr = lane & 15, fq = lane >> 4;
            u32x2 zcur[4];
            { const unsigned voZ = (unsigned)(fr * NPAD + C_SZ + h * 64 + 4 * fq) * 2u;
#pragma unroll
              for (int pt = 0; pt < 4; ++pt) zcur[pt] = ldg<u32x2>(a.ws + WS_PROJ, (R0 + l0) * (size_t)(NPAD * 2) + 32 * pt, voZ); }
            const LAS unsigned char* fb = lds + fr * RS + 16 * fq;
            f32x4 yacc[4];
#pragma unroll
            for (int i = 0; i < 4; ++i) yacc[i] = (f32x4){0.f, 0.f, 0.f, 0.f};
            if (c > 0) {
                bf16x8 cf[4];
#pragma unroll
                for (int k = 0; k < 4; ++k) cf[k] = *(const LAS bf16x8*)(fb + O_CC + l0 * RS + 64 * k);
#pragma unroll
                for (int k = 0; k < 4; ++k)
#pragma unroll
                    for (int pt = 0; pt < 4; ++pt) yacc[pt] = __builtin_amdgcn_mfma_f32_16x16x32_bf16(*(const LAS bf16x8*)(fb + O_HB + 16 * pt * RS + 64 * k), cf[k], yacc[pt], 0, 0, 0);
                const float ea = __builtin_amdgcn_exp2f(tab[l0 + fr]);
#pragma unroll
                for (int pt = 0; pt < 4; ++pt) yacc[pt] *= ea;
            }
            const float dec = __builtin_amdgcn_exp2f(acs_last2);
#pragma unroll
            for (int pt = 0; pt < 4; ++pt) sacc[pt] *= dec;
#pragma unroll
            for (int k = 0; k < 4; ++k) {
                const u32x4 braw = *(const LAS u32x4*)(fb + O_BCT + l0 * RS + 64 * k);
                const f32x4 d0 = *(const LAS f32x4*)(tab + 256 + 32 * k + 8 * fq), d1 = *(const LAS f32x4*)(tab + 260 + 32 * k + 8 * fq);
                union { bf16x8 v; unsigned u[4]; } bt;
                bt.u[0] = pk2(bflo(braw[0]) * d0[0], bfhi(braw[0]) * d0[1]); bt.u[1] = pk2(bflo(braw[1]) * d0[2], bfhi(braw[1]) * d0[3]);
                bt.u[2] = pk2(bflo(braw[2]) * d1[0], bfhi(braw[2]) * d1[1]); bt.u[3] = pk2(bflo(braw[3]) * d1[2], bfhi(braw[3]) * d1[3]);
#pragma unroll
                for (int pt = 0; pt < 4; ++pt) sacc[pt] = __builtin_amdgcn_mfma_f32_16x16x32_bf16(bt.v, *(const LAS bf16x8*)(fb + O_XST + 16 * pt * RS + 64 * k), sacc[pt], 0, 0, 0); }
            const int kmax = wid >> 1;
            for (int k = 0; k <= kmax; ++k) { const bf16x8 mf = *(const LAS bf16x8*)(fb + O_M + l0 * RS + 64 * k);
#pragma unroll
                for (int pt = 0; pt < 4; ++pt) yacc[pt] = __builtin_amdgcn_mfma_f32_16x16x32_bf16(*(const LAS bf16x8*)(fb + O_XST + 16 * pt * RS + 64 * k), mf, yacc[pt], 0, 0, 0); }
            const unsigned voY = (unsigned)(fr * 2048 + h * 64 + 4 * fq) * 2u, voS = (unsigned)(fr * 32 + h) * 4u;
            float ss = 0.f;
#pragma unroll
            for (int pt = 0; pt < 4; ++pt) {
                const u32x2 zr = zcur[pt];
                const float g0 = yacc[pt][0] * silu(bflo(zr[0])), g1 = yacc[pt][1] * silu(bfhi(zr[0])), g2 = yacc[pt][2] * silu(bflo(zr[1])), g3 = yacc[pt][3] * silu(bfhi(zr[1]));
                ss += (g0 * g0 + g1 * g1) + (g2 * g2 + g3 * g3);
                u32x2 o; o.x = pk2(g0, g1); o.y = pk2(g2, g3);
                stg<u32x2>(YSSD, (R0 + l0) * (size_t)(2048 * 2) + 32 * pt, voY, o); }
            ss += __shfl_xor(ss, 16); ss += __shfl_xor(ss, 32);
            if (fq == 0) stg<float>(SSQ, (R0 + l0) * 128, voS, ss);
        }
        __syncthreads();
        if (c < 15) {
            int t_ = threadIdx.x; LAUNDER(t_); const int lane = t_ & 63, fr = lane & 15, fq = lane >> 4;
            LAS unsigned char* hp = lds + O_HB + fr * RS + (l0 + 4 * fq) * 2;
#pragma unroll
            for (int pt = 0; pt < 4; ++pt) { u32x2 o; o.x = pk2(sacc[pt][0], sacc[pt][1]); o.y = pk2(sacc[pt][2], sacc[pt][3]);
                *(LAS u32x2*)(hp + 16 * pt * RS) = o; }
        }
    }
    {
        const int lane = threadIdx.x & 63, fr = lane & 15, fq = lane >> 4;
        float* so = a.out + O_SHP + ((size_t)(b * NHEAD + h) * 64) * 128;
#pragma unroll
        for (int pt = 0; pt < 4; ++pt) *(f32x4*)(so + (size_t)(16 * pt + fr) * 128 + l0 + 4 * fq) = sacc[pt];
    }
    __syncthreads();
}

__device__ __forceinline__ void lru_prompt_item(const Args& a, LAS unsigned char* lds, int b, int nb, int half) {
    const int tid = threadIdx.x, lane = tid & 63, wid = __builtin_amdgcn_readfirstlane(tid >> 6), fr = lane & 15, fq = lane >> 4;
    constexpr int US = 144;
    LAS unsigned char* ub = lds;
    LAS unsigned char* gwl = lds + 18432;
    LAS unsigned char* uf = lds + 27648;
    LAS float* tot = (LAS float*)(lds + 46080);
    const bf16_t* PROJ = (const bf16_t*)(a.ws + WS_PROJ); bf16_t* YLRU = (bf16_t*)(a.ws + WS_YLRU);
    const bf16_t* GWT = (const bf16_t*)(a.ws + WS_GWT) + (size_t)nb * 8192;
    { const int r = tid >> 3, ck = tid & 7; const int srow = r < 32 ? half * 32 + r : 64 + half * 32 + (r - 32);
        *(LAS u32x4*)(gwl + r * US + 16 * ck) = *(const u32x4*)(GWT + (size_t)srow * 64 + 8 * ck); }
    const int tg = tid >> 4, qc = tid & 15;
    const int chq = nb * 64 + 4 * qc;
    f32x4 cwv[4], cbv;
#pragma unroll
    for (int k = 0; k < 4; ++k) cwv[k] = *(const f32x4*)(a.in[I_LCW] + k * 1024 + chq);
    cbv = *(const f32x4*)(a.in[I_LCB] + chq);
    float ba[2], bx[2], cl[2], carry[2];
#pragma unroll
    for (int ci = 0; ci < 2; ++ci) { const int ch = nb * 64 + half * 32 + 16 * ci + fr; ba[ci] = a.in[I_LBA][ch]; bx[ci] = a.in[I_LBX][ch]; cl[ci] = -8.0f * softplus_acc(-a.in[I_LAM][ch]); carry[ci] = 0.f; }
    const int t0w = 16 * wid;
    for (int c = 0; c < 16; ++c) {
        const size_t R0 = (size_t)b * TSEQ + 128 * c;
        u32x2 raw[7];
#pragma unroll
        for (int i = 0; i < 7; ++i) { const int tok = 4 * tg - 3 + i;
            if (c == 0 && tok < 0) raw[i] = (u32x2){0u, 0u};
            else raw[i] = *(const u32x2*)(PROJ + (R0 + tok) * NPAD + C_LX + chq); }
        bf16_t zr[2][4];
#pragma unroll
        for (int ci = 0; ci < 2; ++ci)
#pragma unroll
            for (int r = 0; r < 4; ++r) zr[ci][r] = PROJ[(R0 + t0w + 4 * fq + r) * NPAD + C_LZ + nb * 64 + half * 32 + 16 * ci + fr];
        {
            float o[4][4];
#pragma unroll
            for (int j = 0; j < 4; ++j)
#pragma unroll
                for (int e = 0; e < 4; ++e) o[j][e] = cbv[e] + cwv[0][e] * bfx2(raw[j], e) + cwv[1][e] * bfx2(raw[j + 1], e) + cwv[2][e] * bfx2(raw[j + 2], e) + cwv[3][e] * bfx2(raw[j + 3], e);
#pragma unroll
            for (int j = 0; j < 4; ++j) { u32x2 p; p.x = pk2(o[j][0], o[j][1]); p.y = pk2(o[j][2], o[j][3]);
                *(LAS u32x2*)(ub + (4 * tg + j) * US + 8 * qc) = p;
                if ((qc >> 3) == half) *(LAS f32x4*)(uf + (4 * tg + j) * US + 16 * (qc & 7)) = (f32x4){o[j][0], o[j][1], o[j][2], o[j][3]}; }
        }
        __syncthreads();
        f32x4 ga[4];
#pragma unroll
        for (int jt = 0; jt < 4; ++jt) { ga[jt] = (f32x4){0.f, 0.f, 0.f, 0.f};
#pragma unroll
            for (int k = 0; k < 2; ++k) ga[jt] = __builtin_amdgcn_mfma_f32_16x16x32_bf16(ldfrag(ub, US, t0w, 32 * k, fr, fq), ldfrag(gwl, US, 16 * jt, 32 * k, fr, fq), ga[jt], 0, 0, 0); }
        float Ar[2][4], Br[2][4];
#pragma unroll
        for (int ci = 0; ci < 2; ++ci) {
            float Aacc = 1.f, Bacc = 0.f;
#pragma unroll
            for (int r = 0; r < 4; ++r) {
                const float u = *(const LAS float*)(uf + (t0w + 4 * fq + r) * US + 4 * (16 * ci + fr));
                const float rg = sigm(ga[ci][r] + ba[ci]), ig = sigm(ga[2 + ci][r] + bx[ci]);
                const float la = cl[ci] * rg, av = fexp(la);
                float mult = sqrtf(neg_expm1(2.0f * la));
                if (c == 0 && wid == 0 && fq == 0 && r == 0) mult = 1.0f;
                const float bb = mult * ig * u;
                Bacc = av * Bacc + bb; Aacc = av * Aacc; Ar[ci][r] = Aacc; Br[ci][r] = Bacc; }
        }
        float Ap[2], Bp[2];
#pragma unroll
        for (int ci = 0; ci < 2; ++ci) { Ap[ci] = 1.f; Bp[ci] = 0.f;
#pragma unroll
            for (int k = 0; k < 3; ++k) { const float Ak = __shfl(Ar[ci][3], 16 * k + fr), Bk = __shfl(Br[ci][3], 16 * k + fr); if (k < fq) { Bp[ci] = Ak * Bp[ci] + Bk; Ap[ci] = Ak * Ap[ci]; } }
            if (fq == 3) { LAS float* tp = tot + (((c & 1) * 8 + wid) * 32 + 16 * ci + fr) * 2; tp[0] = Ar[ci][3] * Ap[ci]; tp[1] = Ar[ci][3] * Bp[ci] + Br[ci][3]; } }
        __syncthreads();
#pragma unroll
        for (int ci = 0; ci < 2; ++ci) {
            float hin = carry[ci], hw = 0.f;
#pragma unroll
            for (int w = 0; w < 8; ++w) { const LAS float* tp = tot + (((c & 1) * 8 + w) * 32 + 16 * ci + fr) * 2; if (w == wid) hw = hin; hin = tp[0] * hin + tp[1]; }
            carry[ci] = hin;
            const float hs = Ap[ci] * hw + Bp[ci];
            const int ch = half * 32 + 16 * ci + fr;
#pragma unroll
            for (int r = 0; r < 4; ++r) { const float hv = Ar[ci][r] * hs + Br[ci][r];
                const float y = hv * silu(bf1(zr[ci][r]));
                YLRU[(R0 + t0w + 4 * fq + r) * 1024 + nb * 64 + ch] = (bf16_t)(pk2(y, 0.f) & 0xffffu); }
        }
    }
    if (wid == 0 && fq == 0) {
#pragma unroll
        for (int ci = 0; ci < 2; ++ci) a.out[O_LHP + (size_t)b * 1024 + nb * 64 + half * 32 + 16 * ci + fr] = carry[ci];
    }
    __syncthreads();
}

__device__ __forceinline__ void ssd_sample_item(const Args& a, LAS unsigned char* lds, int b, int h) {
    const int tid = threadIdx.x, lane = tid & 63;
    const int g = h >> 3; const size_t row = (size_t)MP + b;
    LAS float* sv = (LAS float*)lds;
    LAS float* sg = sv + 384;
    const bf16_t* PROJ = (const bf16_t*)(a.ws + WS_PROJ); bf16_t* YSSD = (bf16_t*)(a.ws + WS_YSSD);
    if (tid < 320) {
        const int cch = tid < 64 ? h * 64 + tid : (tid < 192 ? 2048 + g * 128 + (tid - 64) : 2560 + g * 128 + (tid - 192));
        const float* buf = a.in[I_SSC] + (size_t)b * 3 * 3072 + cch; const float* cw = a.in[I_SCW] + cch;
        float v = a.in[I_SCB][cch] + cw[0] * buf[0] + cw[3072] * buf[3072] + cw[2 * 3072] * buf[2 * 3072] + cw[3 * 3072] * bf1(PROJ[row * NPAD + C_XBC + cch]);
        sv[tid] = silu(v);
    } else if (tid < 384) sv[tid] = bf1(PROJ[row * NPAD + C_SZ + h * 64 + (tid - 320)]);
    const float dts = softplus_acc(((const float*)(a.ws + WS_DT))[row * 32 + h] + a.in[I_DTB][h]);
    const float dA = expf(dts * -expf(a.in[I_ALOG][h])), D_h = a.in[I_SD][h];
    __syncthreads();
    const int l32 = tid & 31, prow = tid >> 5, n0 = 4 * l32;
    const float* hin = a.in[I_SSH] + ((size_t)(b * NHEAD + h) * 64) * 128; float* hout = a.out + O_SHS + ((size_t)(b * NHEAD + h) * 64) * 128;
    const f32x4 Bv = *(const LAS f32x4*)(sv + 64 + n0), Cv = *(const LAS f32x4*)(sv + 192 + n0);
    f32x4 h0[4];
#pragma unroll
    for (int ps = 0; ps < 4; ++ps) h0[ps] = *(const f32x4*)(hin + (size_t)(ps * 16 + prow) * 128 + n0);
#pragma unroll
    for (int ps = 0; ps < 4; ++ps) { const int pp = ps * 16 + prow; const float xv = sv[pp], xdt = dts * xv;
        const f32x4 hn = h0[ps] * dA + Bv * xdt;
        *(f32x4*)(hout + (size_t)pp * 128 + n0) = hn;
        float part = (hn[0] * Cv[0] + hn[1] * Cv[1]) + (hn[2] * Cv[2] + hn[3] * Cv[3]);
#pragma unroll
        for (int o = 1; o < 32; o <<= 1) part += __shfl_xor(part, o);
        if (l32 == 0) { const float y = part + D_h * xv; const float gv = y * silu(sv[320 + pp]);
            YSSD[row * 2048 + h * 64 + pp] = (bf16_t)(pk2(gv, 0.f) & 0xffffu); sg[pp] = gv * gv; } }
    __syncthreads();
    if (tid < 64) { const float s = wave_sum(sg[lane]); if (lane == 0) ((float*)(a.ws + WS_SSQ))[row * 32 + h] = s; }
    __syncthreads();
}

__device__ __forceinline__ void lru_sample_item(const Args& a, int b, int nb, int lane) {
    const int ch = nb * 64 + lane; const size_t row = (size_t)MP + b;
    const bf16_t* PROJ = (const bf16_t*)(a.ws + WS_PROJ); bf16_t* YLRU = (bf16_t*)(a.ws + WS_YLRU);
    const float* buf = a.in[I_SLC] + (size_t)b * 3 * 1024 + ch; const float* cw = a.in[I_LCW] + ch;
    const float px = bf1(PROJ[row * NPAD + C_LX + ch]);
    const float b0 = buf[0], b1 = buf[1024], b2 = buf[2048];
    const float u = a.in[I_LCB][ch] + cw[0] * b0 + cw[1024] * b1 + cw[2048] * b2 + cw[3072] * px;
    float gr = a.in[I_LBA][ch], gi = a.in[I_LBX][ch];
    const float* wa = a.in[I_LWA] + (size_t)nb * 4096 + lane; const float* wx = a.in[I_LWX] + (size_t)nb * 4096 + lane;
#pragma unroll 8
    for (int k = 0; k < 64; ++k) { const float uk = __shfl(u, k); gr += uk * wa[k * 64]; gi += uk * wx[k * 64]; }
    const float rg = sigm(gr), ig = sigm(gi);
    const float la = -8.0f * softplus_acc(-a.in[I_LAM][ch]) * rg, av = fexp(la), mult = sqrtf(neg_expm1(2.0f * la));
    const float hv = av * a.in[I_SLH][(size_t)b * 1024 + ch] + mult * ig * u;
    a.out[O_LHS + (size_t)b * 1024 + ch] = hv;
    const float y = hv * silu(bf1(PROJ[row * NPAD + C_LZ + ch]));
    YLRU[row * 1024 + ch] = (bf16_t)(pk2(y, 0.f) & 0xffffu);
    float* lc = a.out + O_LCS + (size_t)b * 3 * 1024 + ch; lc[0] = b1; lc[1024] = b2; lc[2048] = px;
}

#ifndef P3_SUB
#define P3_SUB 63
#endif
#ifndef REP_SUB
#define REP_SUB 63
#endif
__device__ __forceinline__ void p3_ssd_prompt(const Args& a, LAS unsigned char* lds) {
    for (int it = blockIdx.x; it < 256; it += gridDim.x) { const int xcd = it & 7, slot = it >> 3, pair = xcd * 4 + (slot >> 3); ssd_prompt_item(a, lds, pair >> 2, (pair & 3) * 8 + (slot & 7)); }
}
__device__ __forceinline__ void p3_mixers(const Args& a, LAS unsigned char* lds, const int sub) {
    const int tid = threadIdx.x, lane = tid & 63, wid = __builtin_amdgcn_readfirstlane(tid >> 6);
    const int G = gridDim.x, bx = blockIdx.x;
    if (sub & 32) ssd_bc_prepass(a, lds);
    if (sub & 2) for (int it = bx; it < 256; it += G) lru_prompt_item(a, lds, it >> 5, (it >> 1) & 15, it & 1);
    if (sub & 4) for (int it = bx; it < NB_S * NHEAD; it += G) ssd_sample_item(a, lds, it >> 5, it & 31);
    const int gw = bx * 8 + wid, NGW = G * 8;
    if (sub & 8) for (int it = gw; it < NB_S * 16; it += NGW) lru_sample_item(a, it >> 4, it & 15, lane);
    if (!(sub & 16)) return;
    const bf16_t* PROJ = (const bf16_t*)(a.ws + WS_PROJ);
    const int gt = bx * 512 + tid, NGT = G * 512;
    for (int i = gt; i < NB_P * 3 * 1024; i += NGT) { const int bb = i / 3072, j = (i / 1024) % 3, c = i & 1023; a.out[O_LCP + i] = bf1(PROJ[((size_t)bb * TSEQ + 2045 + j) * NPAD + C_LX + c]); }
    for (int i = gt; i < NB_P * 3 * 3072; i += NGT) { const int bb = i / 9216, j = (i / 3072) % 3, c = i % 3072; a.out[O_SCP + i] = bf1(PROJ[((size_t)bb * TSEQ + 2045 + j) * NPAD + C_XBC + c]); }
    for (int i = gt; i < NB_S * 3 * 3072; i += NGT) { const int bb = i / 9216, j = (i / 3072) % 3, c = i % 3072;
        a.out[O_SCS + i] = j < 2 ? a.in[I_SSC][(size_t)bb * 9216 + (j + 1) * 3072 + c] : bf1(PROJ[((size_t)MP + bb) * NPAD + C_XBC + c]); }
}

__device__ __forceinline__ float ms8(const float* p) { const f32x4 a = *(const f32x4*)p, b = *(const f32x4*)(p + 4); return ((a[0] + a[1]) + (a[2] + a[3]) + (b[0] + b[1]) + (b[2] + b[3])) * (1.0f / 512.0f) + RMS_EPS; }
__device__ __forceinline__ void p4_sample(const Args& a, LAS unsigned char* lds) {
    const int tid = threadIdx.x, lane = tid & 63, wid = __builtin_amdgcn_readfirstlane(tid >> 6), fr = lane & 15, fq = lane >> 4;
    const int ct = wid & 1, kq = wid >> 1;
    LAS float* red = (LAS float*)lds;
    const bf16_t* YLRU = (const bf16_t*)(a.ws + WS_YLRU); const bf16_t* YSSD = (const bf16_t*)(a.ws + WS_YSSD);
    const bf16_t* WLRU = (const bf16_t*)(a.ws + WS_WLRU); const bf16_t* WSSD = (const bf16_t*)(a.ws + WS_WSSD);
    const bf16_t* PROJ = (const bf16_t*)(a.ws + WS_PROJ); const float* SSQ = (const float*)(a.ws + WS_SSQ); bf16_t* MG = (bf16_t*)(a.ws + WS_H);
    for (int task = blockIdx.x; task < 256; task += gridDim.x) {
        const int rt = task >> 5, cg = task & 31, row0 = MP + 16 * rt, col0 = 32 * cg + 16 * ct;
        f32x4 pa = (f32x4){0.f, 0.f, 0.f, 0.f}, pb = (f32x4){0.f, 0.f, 0.f, 0.f};
        const bf16_t* ap = YLRU + (size_t)(row0 + fr) * 1024 + 256 * kq + 8 * fq; const bf16_t* bp = WLRU + (size_t)(col0 + fr) * 1024 + 256 * kq + 8 * fq;
#pragma unroll
        for (int s = 0; s < 8; ++s) pa = __builtin_amdgcn_mfma_f32_16x16x32_bf16(*(const bf16x8*)(ap + 32 * s), *(const bf16x8*)(bp + 32 * s), pa, 0, 0, 0);
        const bf16_t* ap2 = YSSD + (size_t)(row0 + fr) * 2048 + 512 * kq + 8 * fq; const bf16_t* bp2 = WSSD + (size_t)(col0 + fr) * 2048 + 512 * kq + 8 * fq;
#pragma unroll
        for (int s = 0; s < 16; ++s) pb = __builtin_amdgcn_mfma_f32_16x16x32_bf16(*(const bf16x8*)(ap2 + 32 * s), *(const bf16x8*)(bp2 + 32 * s), pb, 0, 0, 0);
#pragma unroll
        for (int r = 0; r < 4; ++r) pb[r] *= __builtin_amdgcn_rsqf(ms8(SSQ + (size_t)(row0 + 4 * fq + r) * 32 + 8 * kq));
        *(LAS f32x4*)(red + ((wid * 2 + 0) * 64 + lane) * 4) = pa; *(LAS f32x4*)(red + ((wid * 2 + 1) * 64 + lane) * 4) = pb;
        __syncthreads();
        if (tid < 128) {
            f32x4 sa = (f32x4){0.f, 0.f, 0.f, 0.f}, sb = sa;
#pragma unroll
            for (int q = 0; q < 4; ++q) { const int w = q * 2 + wid; sa += *(const LAS f32x4*)(red + ((w * 2 + 0) * 64 + lane) * 4); sb += *(const LAS f32x4*)(red + ((w * 2 + 1) * 64 + lane) * 4); }
#pragma unroll
            for (int r = 0; r < 4; ++r) { const size_t row = row0 + 4 * fq + r; const int col = 32 * cg + 16 * wid + fr;
                const float gA = sigm(bf1(PROJ[row * NPAD + C_MG + col])), gB = sigm(bf1(PROJ[row * NPAD + C_MG + 1024 + col]));
                MG[row * 1024 + col] = (bf16_t)(pk2(gA * sa[r] + gB * sb[r], 0.f) & 0xffffu); }
        }
        __syncthreads();
    }
}
__device__ __forceinline__ void p5_sample(const Args& a, LAS unsigned char* lds) {
    const int tid = threadIdx.x, lane = tid & 63, wid = __builtin_amdgcn_readfirstlane(tid >> 6), fr = lane & 15, fq = lane >> 4;
    const int ct = wid & 1, kq = wid >> 1;
    LAS float* red = (LAS float*)lds;
    const bf16_t* MG = (const bf16_t*)(a.ws + WS_H); const bf16_t* WOUT = (const bf16_t*)(a.ws + WS_WOUT); const float* MOD = (const float*)(a.ws + WS_MOD);
    for (int task = blockIdx.x; task < 256; task += gridDim.x) {
        const int rt = task >> 5, cg = task & 31, row0 = MP + 16 * rt, col0 = 32 * cg + 16 * ct;
        f32x4 pa = (f32x4){0.f, 0.f, 0.f, 0.f};
        const bf16_t* ap = MG + (size_t)(row0 + fr) * 1024 + 256 * kq + 8 * fq; const bf16_t* bp = WOUT + (size_t)(col0 + fr) * 1024 + 256 * kq + 8 * fq;
#pragma unroll
        for (int s = 0; s < 8; ++s) pa = __builtin_amdgcn_mfma_f32_16x16x32_bf16(*(const bf16x8*)(ap + 32 * s), *(const bf16x8*)(bp + 32 * s), pa, 0, 0, 0);
        *(LAS f32x4*)(red + (wid * 64 + lane) * 4) = pa;
        __syncthreads();
        if (tid < 128) {
            f32x4 sa = (f32x4){0.f, 0.f, 0.f, 0.f};
#pragma unroll
            for (int q = 0; q < 4; ++q) sa += *(const LAS f32x4*)(red + (((q * 2 + wid)) * 64 + lane) * 4);
#pragma unroll
            for (int r = 0; r < 4; ++r) { const int rs = row0 - MP + 4 * fq + r; const int col = 32 * cg + 16 * wid + fr;
                a.out[(size_t)(MP + rs) * D + col] = ALPHA * a.in[I_XS][(size_t)rs * D + col] + MOD[(size_t)(8 + rs) * 3072 + 2048 + col] * sa[r]; }
        }
        __syncthreads();
    }
}

__device__ __forceinline__ void p6_layernorm(const Args& a) {
    const int tid = threadIdx.x, lane = tid & 63, wid = __builtin_amdgcn_readfirstlane(tid >> 6);
    const int gw = blockIdx.x * 8 + wid, NGW = gridDim.x * 8;
    const float* lg = a.in[I_LNG]; const float* lb = a.in[I_LNB];
    for (int row = gw; row < MTOT; row += NGW) {
        float* p = a.out + (size_t)row * D;
        f32x4 v[4]; float s = 0.f;
#pragma unroll
        for (int j = 0; j < 4; ++j) { v[j] = *(const f32x4*)(p + 4 * lane + 256 * j); s += (v[j][0] + v[j][1]) + (v[j][2] + v[j][3]); }
        const float mean = wave_sum(s) * (1.f / D); float s2 = 0.f;
#pragma unroll
        for (int j = 0; j < 4; ++j) { v[j] = v[j] - mean; s2 += (v[j][0] * v[j][0] + v[j][1] * v[j][1]) + (v[j][2] * v[j][2] + v[j][3] * v[j][3]); }
        const float rstd = __builtin_amdgcn_rsqf(wave_sum(s2) * (1.f / D) + LN_EPS);
#pragma unroll
        for (int j = 0; j < 4; ++j) { const int c = 4 * lane + 256 * j; const f32x4 gv = *(const f32x4*)(lg + c), bv = *(const f32x4*)(lb + c);
            *(f32x4*)(p + c) = v[j] * rstd * gv + bv; }
    }
}

__global__ void __launch_bounds__(512, 2) fwd(Args args) {
    extern __shared__ __attribute__((aligned(16))) unsigned char lds_raw[];
    LAS unsigned char* lds = (LAS unsigned char*)lds_raw;
    volatile LAS unsigned* MISC = (volatile LAS unsigned*)(lds + MISC_OFF);
    const int tid = threadIdx.x;
    if (tid < 64) MISC[tid] = 0u;
    __syncthreads();
    unsigned* ctl = (unsigned*)(args.ws + WS_CTL);
    XcdBarrier bar; bar.bar = ctl + 1024; bar.x = 0; bar.st = nullptr;
    if (N_LAUNCHES == 1) bar = xcd_barrier_post(ctl + 1024, MISC + 8);
    const int lo = args.ph_lo, hi = args.ph_hi;
#ifndef ONLY_PHASE
#define ONLY_PHASE -1
#endif
#define IN(k) ((ONLY_PHASE < 0 || ONLY_PHASE == (k)) && lo <= (k) && (k) < hi)
#define SEAM(k) do { if (IN(k) && IN((k) + 1)) xcd_barrier(bar); } while (0)
    const int G = gridDim.x;
#ifndef REP_PHASE
#define REP_PHASE -1
#endif
#define NREP(k) ((REP_PHASE == (k)) ? 2 : 1)
    if (IN(0)) { for (int rp = 0; rp < NREP(0); ++rp) { p0_prep(args, lds); __syncthreads(); } } SEAM(0);
    if (IN(1)) { for (int rp = 0; rp < NREP(1); ++rp) p1_modulate(args); } SEAM(1);
    if (IN(2)) for (int rp = 0; rp < NREP(2); ++rp) {
        pg8::Gemm g{(const pg8::bf16_t*)(args.ws + WS_H), (const pg8::bf16_t*)(args.ws + WS_WIN), MPAD, NPAD, 1024};
        pg8::StaticOrder S; S.init(MPAD, NPAD, G, (int)blockIdx.x);
        EpiProj E{(bf16_t*)(args.ws + WS_PROJ), (float*)(args.ws + WS_DT)};
        pg8::gemm_phase<EpiProj, pg8::StaticOrder, true, true>(lds, g, S, E);
    } SEAM(2);
    if (IN(3)) { p3_mixers(args, lds, P3_SUB);
#if REP_PHASE == 3
        __syncthreads(); p3_mixers(args, lds, REP_SUB);
#endif
    } SEAM(3);
    if (IN(4)) { for (int rp = 0; rp < NREP(4); ++rp) p3_ssd_prompt(args, lds); } SEAM(4);
    if (IN(5)) for (int rp = 0; rp < NREP(5); ++rp) {
        p4_sample(args, lds);
        pg8::StaticOrder S; S.init(MP, 1024, G, (int)blockIdx.x);
        { pg8::Gemm g{(const pg8::bf16_t*)(args.ws + WS_YLRU), (const pg8::bf16_t*)(args.ws + WS_WLRU), MP, 1024, 1024};
          EpiLruT E{(bf16_t*)(args.ws + WS_TBUF), (const bf16_t*)(args.ws + WS_PROJ)};
          pg8::gemm_phase<EpiLruT, pg8::StaticOrder, true, true>(lds, g, S, E); }
        VM_WAIT(); __syncthreads();
        { pg8::Gemm g{(const pg8::bf16_t*)(args.ws + WS_YSSD), (const pg8::bf16_t*)(args.ws + WS_WSSD), MP, 1024, 2048};
          EpiMerge E{(bf16_t*)(args.ws + WS_H), (const bf16_t*)(args.ws + WS_TBUF), (const bf16_t*)(args.ws + WS_PROJ), (const float*)(args.ws + WS_SSQ)};
          pg8::gemm_phase<EpiMerge, pg8::StaticOrder, true, true>(lds, g, S, E); }
    } SEAM(5);
    if (IN(6)) for (int rp = 0; rp < NREP(6); ++rp) {
        p5_sample(args, lds);
        pg8::Gemm g{(const pg8::bf16_t*)(args.ws + WS_H), (const pg8::bf16_t*)(args.ws + WS_WOUT), MP, 1024, 1024};
        pg8::StaticOrder S; S.init(MP, 1024, G, (int)blockIdx.x);
        EpiOut E{args.out, args.in[I_XP], args.in[I_XS], (const float*)(args.ws + WS_MOD)};
        pg8::gemm_phase<EpiOut, pg8::StaticOrder, true, true>(lds, g, S, E);
    } SEAM(6);
    if (IN(7)) { p6_layernorm(args); }
#undef IN
#undef SEAM
}

extern "C" void kernel_launch(void* const* d_in, const int* in_sizes, int n_in, void* d_out, int out_size, void* d_ws, size_t ws_size, hipStream_t stream) {
    static int grid = 0;
    if (grid == 0) {
        if (n_in != 29 || (size_t)out_size != O_END || ws_size < WS_END) { fprintf(stderr, "kernel_launch: unexpected shapes: n_in %d out %d ws %zu (need %zu)\n", n_in, out_size, ws_size, (size_t)WS_END); grid = -1; return; }
        int dev = 0, cus = 0, per_cu = 0;
        if (hipGetDevice(&dev) != hipSuccess || hipDeviceGetAttribute(&cus, hipDeviceAttributeMultiprocessorCount, dev) != hipSuccess) { grid = -1; return; }
        if (hipFuncSetAttribute((const void*)fwd, hipFuncAttributeMaxDynamicSharedMemorySize, LDS_BYTES) != hipSuccess) { fprintf(stderr, "kernel_launch: hipFuncSetAttribute failed\n"); grid = -1; return; }
        if (hipOccupancyMaxActiveBlocksPerMultiprocessor(&per_cu, (const void*)fwd, 512, LDS_BYTES) != hipSuccess || per_cu < 1) { fprintf(stderr, "kernel_launch: occupancy query says %d blocks per CU\n", per_cu); (void)hipGetLastError(); per_cu = 1; }
        grid = cus;
    }
    if (grid < 0) return;
    (void)hipMemsetAsync((char*)d_ws + WS_CTL, 0, CTL_ZERO_BYTES, stream);
    Args a{};
    for (int i = 0; i < 29; ++i) a.in[i] = (const float*)d_in[i];
    a.out = (float*)d_out; a.ws = (unsigned char*)d_ws;
    if (N_LAUNCHES == 1) {
        a.ph_lo = 0; a.ph_hi = N_PHASES;
        void* kargs[] = {&a};
        hipError_t e = hipLaunchCooperativeKernel((const void*)fwd, dim3(grid), dim3(512), kargs, LDS_BYTES, stream);
        if (e != hipSuccess) fprintf(stderr, "kernel_launch: cooperative launch failed: %s (grid %d)\n", hipGetErrorString(e), grid);
    } else {
        for (int ph = 0; ph < N_PHASES; ++ph) { a.ph_lo = ph; a.ph_hi = ph + 1; hipLaunchKernelGGL(fwd, dim3(grid), dim3(512), LDS_BYTES, stream, a); }
    }
}
```
